# Optimizing an MI355X kernel written in HIP

```python
import math
import jax, jax.numpy as jnp
from jax import lax
import numpy as np

D_MODEL = 2048
BATCH = 8
SEQ = 4096
DEPTH = 2

CTX_LEN = 256
GRID_W = 64
HEAD_DIM = 128
N_GROUPS = 4
GROUP_WIDTH = D_MODEL // N_GROUPS
MIX_WIDTH = N_GROUPS * GROUP_WIDTH
Q_BLOCK = 128
WINDOW = 128
ROPE_THETA = 10000.0
EPS = 1e-6
NEG_INF = -1e30

A_HEADS = GROUP_WIDTH // HEAD_DIM
A_KV_HEADS = A_HEADS // 2
B_HEADS = GROUP_WIDTH // HEAD_DIM
B_V_DIM = HEAD_DIM
B_QK_DIM = B_V_DIM // 2
C_HEADS = GROUP_WIDTH // HEAD_DIM
C_Q_LORA = 448
C_KV_LORA = 128
C_NOPE = 128
C_ROPE = 64
C_V = GROUP_WIDTH // C_HEADS
D_HEADS = GROUP_WIDTH // HEAD_DIM
D_KV_HEADS = 2

IN_SIZES = (A_HEADS * HEAD_DIM, A_KV_HEADS * HEAD_DIM, A_KV_HEADS * HEAD_DIM, GROUP_WIDTH,
            2 * B_HEADS * B_QK_DIM, 2 * B_HEADS * B_QK_DIM, B_HEADS * B_V_DIM, GROUP_WIDTH,
            C_Q_LORA, C_KV_LORA, C_ROPE, GROUP_WIDTH,
            D_HEADS * HEAD_DIM, D_KV_HEADS * HEAD_DIM, D_KV_HEADS * HEAD_DIM, GROUP_WIDTH)
IN_WIDTH = sum(IN_SIZES)

kernel_name = 'hybrid_parallel_heads_dit_ctx_prefix'


def rms_norm(x, g, eps=EPS):
    xf = x.astype(jnp.float32)
    y = xf * lax.rsqrt(jnp.mean(xf * xf, axis=-1, keepdims=True) + eps)
    return (y * g.astype(jnp.float32)).astype(x.dtype)


def axial_rope_tables(rows, rot_dim):
    row = jnp.broadcast_to(jnp.arange(rows)[:, None], (rows, GRID_W)).reshape(-1).astype(jnp.float32)
    col = jnp.broadcast_to(jnp.arange(GRID_W)[None, :], (rows, GRID_W)).reshape(-1).astype(jnp.float32)
    axis_dim = rot_dim // 2
    inv_freq = ROPE_THETA ** (-jnp.arange(0, axis_dim, 2, dtype=jnp.float32) / axis_dim)
    ang_r = row[:, None] * inv_freq[None, :]
    ang_c = col[:, None] * inv_freq[None, :]
    ang = jnp.concatenate([ang_r, ang_r, ang_c, ang_c], axis=-1)
    return jnp.cos(ang), jnp.sin(ang)


def apply_rope(x, rope):
    cos, sin = rope
    x1, x2, x3, x4 = jnp.split(x, 4, axis=-1)
    rot = jnp.concatenate([-x2, x1, -x4, x3], axis=-1)
    return (x * cos[:, None, :] + rot * sin[:, None, :]).astype(x.dtype)


def split_cols(y, sizes):
    cuts = [int(v) for v in np.cumsum(sizes)[:-1]]
    return jnp.split(y, cuts, axis=-1)


def branch_inputs(h, w_in, cq_g, ckv_g, w_uq, w_ukv, dq_g, dk_g, ropes):
    B, T, _ = h.shape
    (a_q, a_k, a_v, a_z, b_q, b_k, b_v, b_z,
     c_cq, c_ckv, c_kr, c_z, d_q, d_k, d_v, d_z) = split_cols(h @ w_in, IN_SIZES)
    a_q = a_q.reshape(B, T, A_HEADS, HEAD_DIM)
    a_k = a_k.reshape(B, T, A_KV_HEADS, HEAD_DIM)
    a_v = a_v.reshape(B, T, A_KV_HEADS, HEAD_DIM)
    b_q = b_q.reshape(B, T, 2 * B_HEADS, B_QK_DIM)
    b_k = b_k.reshape(B, T, 2 * B_HEADS, B_QK_DIM)
    b_v = b_v.reshape(B, T, B_HEADS, B_V_DIM)
    c_qh = (rms_norm(c_cq, cq_g) @ w_uq).reshape(B, T, C_HEADS, C_NOPE + C_ROPE)
    c_q_nope, c_q_rope = c_qh[..., :C_NOPE], c_qh[..., C_NOPE:]
    c_kvh = (rms_norm(c_ckv, ckv_g) @ w_ukv).reshape(B, T, C_HEADS, C_NOPE + C_V)
    c_k_nope, c_v = c_kvh[..., :C_NOPE], c_kvh[..., C_NOPE:]
    c_kr = c_kr.reshape(B, T, 1, C_ROPE)
    d_q = rms_norm(d_q.reshape(B, T, D_HEADS, HEAD_DIM), dq_g)
    d_k = rms_norm(d_k.reshape(B, T, D_KV_HEADS, HEAD_DIM), dk_g)
    d_v = d_v.reshape(B, T, D_KV_HEADS, HEAD_DIM)
    if ropes is not None:
        rope_h, rope_b, rope_c = ropes
        a_q, a_k = apply_rope(a_q, rope_h), apply_rope(a_k, rope_h)
        b_q, b_k = apply_rope(b_q, rope_b), apply_rope(b_k, rope_b)
        c_q_rope, c_kr = apply_rope(c_q_rope, rope_c), apply_rope(c_kr, rope_c)
        d_q, d_k = apply_rope(d_q, rope_h), apply_rope(d_k, rope_h)
    c_q = jnp.concatenate([c_q_nope, c_q_rope], axis=-1)[:, :, :, None, :]
    c_k = jnp.concatenate([c_k_nope, jnp.broadcast_to(c_kr, (B, T, C_HEADS, C_ROPE))], axis=-1)
    return {
        'a_q': a_q.reshape(B, T, A_KV_HEADS, A_HEADS // A_KV_HEADS, HEAD_DIM), 'a_k': a_k, 'a_v': a_v, 'a_z': a_z,
        'b_q': b_q.reshape(B, T, B_HEADS, 2, B_QK_DIM), 'b_k': b_k.reshape(B, T, B_HEADS, 2, B_QK_DIM),
        'b_v': b_v, 'b_z': b_z,
        'c_q': c_q, 'c_k': c_k, 'c_v': c_v, 'c_z': c_z,
        'd_q': d_q.reshape(B, T, D_KV_HEADS, D_HEADS // D_KV_HEADS, HEAD_DIM), 'd_k': d_k, 'd_v': d_v, 'd_z': d_z,
    }


def block_attention(q, k, v, sink=None):
    B, S, Hkv, G, dk = q.shape
    nb = S // Q_BLOCK
    scale = 1.0 / math.sqrt(dk)
    qb = jnp.moveaxis(q.reshape(B, nb, Q_BLOCK, Hkv, G, dk), 1, 0)
    n_keys = k.shape[1]

    def one(qi):
        s = jnp.einsum('bqhgd,bkhd->bhgqk', qi, k, preferred_element_type=jnp.float32) * scale
        if sink is not None:
            s_sink = jnp.broadcast_to(sink.astype(jnp.float32)[None, :, :, None, None], s.shape[:-1] + (1,))
            s = jnp.concatenate([s, s_sink], axis=-1)
        p = jax.nn.softmax(s, axis=-1)[..., :n_keys]
        return jnp.einsum('bhgqk,bkhd->bqhgd', p.astype(v.dtype), v)

    o = lax.map(one, qb)
    return jnp.moveaxis(o, 0, 1).reshape(B, S, Hkv, G, v.shape[-1])


def windowed_attention(q, k, v, k_ctx, v_ctx, sink):
    B, S, Hkv, G, d = q.shape
    nb = S // Q_BLOCK
    n_ctx = k_ctx.shape[1]
    scale = 1.0 / math.sqrt(d)
    qb = q.reshape(B, nb, Q_BLOCK, Hkv, G, d)
    pad = [(0, 0), (Q_BLOCK, Q_BLOCK), (0, 0), (0, 0)]
    kb = jnp.pad(k, pad).reshape(B, nb + 2, Q_BLOCK, Hkv, d)
    vb = jnp.pad(v, pad).reshape(B, nb + 2, Q_BLOCK, Hkv, d)
    k_band = jnp.concatenate([kb[:, :-2], kb[:, 1:-1], kb[:, 2:]], axis=2)
    v_band = jnp.concatenate([vb[:, :-2], vb[:, 1:-1], vb[:, 2:]], axis=2)
    blk = jnp.arange(nb)[:, None]
    qpos = blk * Q_BLOCK + jnp.arange(Q_BLOCK)[None, :]
    kpos = (blk - 1) * Q_BLOCK + jnp.arange(3 * Q_BLOCK)[None, :]
    valid = ((jnp.abs(qpos[:, :, None] - kpos[:, None, :]) <= WINDOW)
             & (kpos >= 0)[:, None, :] & (kpos < S)[:, None, :])
    s_band = jnp.einsum('bnqhgd,bnkhd->bnhgqk', qb, k_band, preferred_element_type=jnp.float32) * scale
    s_band = jnp.where(valid[None, :, None, None], s_band, NEG_INF)
    s_ctx = jnp.einsum('bnqhgd,bkhd->bnhgqk', qb, k_ctx, preferred_element_type=jnp.float32) * scale
    s_sink = jnp.broadcast_to(sink.astype(jnp.float32)[None, None, :, :, None, None], s_ctx.shape[:-1] + (1,))
    p = jax.nn.softmax(jnp.concatenate([s_ctx, s_band, s_sink], axis=-1), axis=-1)
    p_ctx = p[..., :n_ctx].astype(v.dtype)
    p_band = p[..., n_ctx:n_ctx + 3 * Q_BLOCK].astype(v.dtype)
    o = (jnp.einsum('bnhgqk,bkhd->bnqhgd', p_ctx, v_ctx)
         + jnp.einsum('bnhgqk,bnkhd->bnqhgd', p_band, v_band))
    return o.reshape(B, S, Hkv, G, d)


def diff_block_attention(q, k, v, lam):
    B, S, H, _, dk = q.shape
    nb = S // Q_BLOCK
    scale = 1.0 / math.sqrt(dk)
    qb = jnp.moveaxis(q.reshape(B, nb, Q_BLOCK, H, 2, dk), 1, 0)

    def one(qi):
        s = jnp.einsum('bqhcd,bkhcd->bhcqk', qi, k, preferred_element_type=jnp.float32) * scale
        p = jax.nn.softmax(s, axis=-1)
        a = p[:, :, 0] - lam * p[:, :, 1]
        return jnp.einsum('bhqk,bkhd->bqhd', a.astype(v.dtype), v)

    o = lax.map(one, qb)
    return jnp.moveaxis(o, 0, 1).reshape(B, S, H, v.shape[-1])


def mixers(p, pc, sink, lam, lam_init, subln_g, latent):
    B, T = p['a_z'].shape[:2]
    if latent:
        a_o = windowed_attention(p['a_q'], p['a_k'], p['a_v'], pc['a_k'], pc['a_v'], sink)
        keys = lambda name: jnp.concatenate([pc[name], p[name]], axis=1)
    else:
        a_o = block_attention(p['a_q'], p['a_k'], p['a_v'], sink=sink)
        keys = lambda name: pc[name]
    b_o = diff_block_attention(p['b_q'], keys('b_k'), keys('b_v'), lam)
    b_o = rms_norm(b_o, subln_g) * (1.0 - lam_init)
    c_o = block_attention(p['c_q'], keys('c_k'), keys('c_v'))
    d_o = block_attention(p['d_q'], keys('d_k'), keys('d_v'))
    return jnp.concatenate([
        a_o.reshape(B, T, GROUP_WIDTH) * jax.nn.silu(p['a_z']),
        b_o.reshape(B, T, GROUP_WIDTH) * jax.nn.silu(p['b_z']),
        c_o.reshape(B, T, GROUP_WIDTH) * jax.nn.silu(p['c_z']),
        d_o.reshape(B, T, GROUP_WIDTH) * jax.nn.silu(p['d_z']),
    ], axis=-1)


def setup_inputs(seed: int = 0) -> dict:
    key = jax.random.key(seed)
    ks = jax.random.split(key, 19)
    f32 = jnp.float32

    def nrm(k, shape, scale):
        return jax.random.normal(k, shape, f32) * scale

    def gain(k, shape):
        return 1.0 + 0.05 * jax.random.normal(k, shape, f32)

    return {
        'x': nrm(ks[0], (BATCH, SEQ, D_MODEL), 1.0),
        'c': nrm(ks[1], (BATCH, D_MODEL), 1.0),
        'ctx': nrm(ks[2], (BATCH, CTX_LEN, D_MODEL), 1.0),
        'c_ctx': nrm(ks[3], (D_MODEL,), 1.0),
        'w_mod': nrm(ks[4], (DEPTH, D_MODEL, 3 * D_MODEL), 0.2 * D_MODEL ** -0.5),
        'b_mod': nrm(ks[5], (DEPTH, 3 * D_MODEL), 0.02),
        'norm_g': gain(ks[6], (DEPTH, D_MODEL)),
        'w_in': nrm(ks[7], (DEPTH, D_MODEL, IN_WIDTH), D_MODEL ** -0.5),
        'c_q_norm_g': gain(ks[8], (DEPTH, C_Q_LORA)),
        'c_kv_norm_g': gain(ks[9], (DEPTH, C_KV_LORA)),
        'c_w_uq': nrm(ks[10], (DEPTH, C_Q_LORA, C_HEADS * (C_NOPE + C_ROPE)), C_Q_LORA ** -0.5),
        'c_w_ukv': nrm(ks[11], (DEPTH, C_KV_LORA, C_HEADS * (C_NOPE + C_V)), C_KV_LORA ** -0.5),
        'd_q_norm_g': gain(ks[12], (DEPTH, HEAD_DIM)),
        'd_k_norm_g': gain(ks[13], (DEPTH, HEAD_DIM)),
        'a_sink': nrm(ks[14], (DEPTH, A_HEADS), 0.5),
        'b_lambda': nrm(ks[15], (DEPTH, 4, B_QK_DIM), 0.1),
        'b_subln_g': gain(ks[16], (DEPTH, B_V_DIM)),
        'w_out': nrm(ks[17], (DEPTH, MIX_WIDTH, D_MODEL), MIX_WIDTH ** -0.5),
        'final_norm_g': gain(ks[18], (D_MODEL,)),
    }


def reference(x, c, ctx, c_ctx, w_mod, b_mod, norm_g, w_in, c_q_norm_g, c_kv_norm_g,
              c_w_uq, c_w_ukv, d_q_norm_g, d_k_norm_g, a_sink, b_lambda, b_subln_g,
              w_out, final_norm_g):
    B, S, _ = x.shape
    ROWS = S // GRID_W
    rope_h = axial_rope_tables(ROWS, HEAD_DIM)
    rope_b = axial_rope_tables(ROWS, B_QK_DIM)
    rope_c = axial_rope_tables(ROWS, C_ROPE)
    for l in range(DEPTH):
        last = l == DEPTH - 1
        shift_x, scale_x, gate_x = jnp.split(jax.nn.silu(c) @ w_mod[l] + b_mod[l], 3, axis=-1)
        shift_c, scale_c, gate_c = jnp.split(jax.nn.silu(c_ctx) @ w_mod[l] + b_mod[l], 3, axis=-1)
        hx = rms_norm(x, norm_g[l]) * (1.0 + scale_x[:, None, :]) + shift_x[:, None, :]
        hc = rms_norm(ctx, norm_g[l]) * (1.0 + scale_c) + shift_c
        lw = (w_in[l], c_q_norm_g[l], c_kv_norm_g[l], c_w_uq[l], c_w_ukv[l], d_q_norm_g[l], d_k_norm_g[l])
        px = branch_inputs(hx, *lw, ropes=(rope_h, rope_b, rope_c))
        pc = branch_inputs(hc, *lw, ropes=None)
        lam_init = 0.8 - 0.6 * math.exp(-0.3 * l)
        lq1, lk1, lq2, lk2 = b_lambda[l].astype(jnp.float32)
        lam = jnp.exp(jnp.sum(lq1 * lk1)) - jnp.exp(jnp.sum(lq2 * lk2)) + lam_init
        sink = a_sink[l].reshape(A_KV_HEADS, A_HEADS // A_KV_HEADS)
        ux = mixers(px, pc, sink, lam, lam_init, b_subln_g[l], latent=True)
        if not last:
            uc = mixers(pc, pc, sink, lam, lam_init, b_subln_g[l], latent=False)
            ctx = ctx + gate_c * (uc @ w_out[l])
        x = x + gate_x[:, None, :] * (ux @ w_out[l])
    return rms_norm(x, final_norm_g)
```

```cpp
#include <hip/hip_runtime.h>
#include <hip/hip_cooperative_groups.h>
#include <cstdio>
namespace cg = cooperative_groups;

#ifndef PROBE_UNIFORM
#define PROBE_UNIFORM 0
#endif
#ifndef DUP_ATTN
#define DUP_ATTN 0
#endif
#ifndef DUP_GEMM
#define DUP_GEMM 0
#endif
#ifndef DUP_MISC
#define DUP_MISC 0
#endif
#ifndef PROBE_FP8
#define PROBE_FP8 0
#endif
#ifndef COOP
#define COOP 1
#endif

#define DI __device__ __forceinline__
#define LAS __attribute__((address_space(3)))
typedef unsigned short bf16_t;
typedef short bf16x8 __attribute__((ext_vector_type(8)));
typedef short s16x4 __attribute__((ext_vector_type(4)));
typedef float f32x4 __attribute__((ext_vector_type(4)));
typedef float f32x8 __attribute__((ext_vector_type(8)));
typedef float f32x16 __attribute__((ext_vector_type(16)));
typedef unsigned u32x4 __attribute__((ext_vector_type(4)));
typedef unsigned u32x2 __attribute__((ext_vector_type(2)));

constexpr int DM = 2048, NB = 8, SEQ = 4096, NCTX = 256;
constexpr int MCTX = NB * NCTX;
constexpr int MLAT = NB * SEQ;
constexpr int MTOT = MCTX + MLAT;
constexpr int NIN = 6272, NINP = 6400;
constexpr float EPS = 1e-6f;
constexpr int C_AQ = 0, C_AK = 512, C_AV = 768, C_AZ = 1024, C_BQ = 1536, C_BK = 2048, C_BV = 2560, C_BZ = 3072;
constexpr int C_CQ = 3584, C_CKV = 4032, C_KR = 4160, C_CZ = 4224, C_DQ = 4736, C_DK = 5248, C_DV = 5504, C_DZ = 5760;
static_assert(C_DZ + 512 == NIN, "cols");

constexpr size_t al256(size_t x) { return (x + 255) / 256 * 256; }
constexpr int N8 = 4224, N8P = 4352;
constexpr size_t SZ_WIN8 = (size_t)N8P * DM, SZ_WINZ = (size_t)DM * DM * 2;
constexpr size_t SZ_WIN = SZ_WIN8 + SZ_WINZ, SZ_WOUT = (size_t)DM * DM * 2, SZ_WUQ = (size_t)768 * 512 * 2, SZ_WUKV = (size_t)1024 * 256 * 2;
constexpr size_t WS_WIN = 0;
constexpr size_t WS_WOUT = WS_WIN + 2 * SZ_WIN;
constexpr size_t WS_WUQ = WS_WOUT + 2 * SZ_WOUT;
constexpr size_t WS_WUKV = WS_WUQ + 2 * SZ_WUQ;
constexpr size_t WS_BAR = WS_WUKV + 2 * SZ_WUKV;
constexpr size_t WS_MOD = WS_BAR + 16384;
constexpr size_t SZ_MOD = (size_t)2 * 9 * 6144 * 4;
constexpr size_t WS_ROPE = al256(WS_MOD + SZ_MOD);
constexpr size_t WS_H = al256(WS_ROPE + 6144 * 4);
constexpr size_t WS_PROJ = WS_H + (size_t)MTOT * DM * 2;
constexpr size_t WS_CQN = WS_PROJ + (size_t)MTOT * NIN * 2;
constexpr size_t WS_CKVN = WS_CQN + (size_t)MTOT * 512 * 2;
constexpr size_t WS_CQH = WS_CKVN + (size_t)MTOT * 256 * 2;
constexpr size_t WS_CKVH = WS_CQH + (size_t)MTOT * 768 * 2;
constexpr size_t WS_CTX1 = WS_CKVH + (size_t)MTOT * 1024 * 2;
constexpr size_t WS_DIFF = WS_CTX1 + (size_t)MCTX * DM * 4;
constexpr size_t WS_H8 = WS_DIFF + (size_t)256 * 32768 * 4;
constexpr size_t WS_END = WS_H8 + (size_t)MTOT * DM;

constexpr int LDS_BYTES = 131072;

struct Args { const float* in[19]; float* out; unsigned char* ws; int ph_lo, ph_hi; };
enum { I_X = 0, I_C, I_CTX, I_CCTX, I_WMOD, I_BMOD, I_NORMG, I_WIN, I_CQG, I_CKVG, I_WUQ, I_WUKV, I_DQG, I_DKG, I_SINK, I_LAMBDA, I_SUBLN, I_WOUT, I_FNG };

DI float bf2f(bf16_t b) { return __uint_as_float(((unsigned)b) << 16); }
DI unsigned cvtpk(float lo, float hi) { unsigned r; asm volatile("v_cvt_pk_bf16_f32 %0, %1, %2" : "=v"(r) : "v"(lo), "v"(hi)); return r; }
DI bf16_t f2bf(float x) { return (bf16_t)(cvtpk(x, x) & 0xffffu); }
DI void unpack8(u32x4 w, float* f) {
#pragma unroll
  for (int i = 0; i < 4; ++i) { f[2 * i] = __uint_as_float(w[i] << 16); f[2 * i + 1] = __uint_as_float(w[i] & 0xffff0000u); }
}
DI u32x4 pack8(const float* f) { u32x4 w = {cvtpk(f[0], f[1]), cvtpk(f[2], f[3]), cvtpk(f[4], f[5]), cvtpk(f[6], f[7])}; return w; }
typedef int v8i32 __attribute__((ext_vector_type(8)));
DI int lane_id() { int l; asm volatile("v_mbcnt_lo_u32_b32 %0, -1, 0\n\tv_mbcnt_hi_u32_b32 %0, -1, %0" : "=v"(l)); return l; }
DI unsigned cvt4_fp8(float a, float b, float c, float d) { int w = __builtin_amdgcn_cvt_pk_fp8_f32(a, b, 0, false); w = __builtin_amdgcn_cvt_pk_fp8_f32(c, d, w, true); return (unsigned)w; }
constexpr float A8_SCALE = 4.f, W8_SCALE = 32.f;
DI int map8(int n8) { return n8 < 1024 ? n8 : (n8 < 2560 ? n8 + 512 : (n8 < 3200 ? n8 + 1024 : n8 + 1536)); }
DI int mapz(int nz) { const int sg = nz >> 9; const int zb = sg == 0 ? C_AZ : (sg == 1 ? C_BZ : (sg == 2 ? C_CZ : C_DZ)); return zb + (nz & 511); }
DI float shfl_xor_l(float v, int m, int lane) { return __int_as_float(__builtin_amdgcn_ds_bpermute((lane ^ m) << 2, __float_as_int(v))); }
DI float wave_sum(float v, int lane) {
#pragma unroll
  for (int m = 32; m >= 1; m >>= 1) v += shfl_xor_l(v, m, lane);
  return v;
}
DI float silu(float z) { return z / (1.f + __expf(-z)); }


#define XB_TMO      128
#define XB_XCNT(j)  (256  + 64 * (j))
#define XB_XSUB(j)  (1280 + 64 * (j))
#define XB_XGEN(j)  (2304 + 64 * (j))
#define XB_TOP      3328
#define XB_TOPGEN   3392
#define XCD_BAR_WORDS 3456
#define XB_SPIN_CAP (1u << 22)
DI unsigned xb_ld(unsigned* p)              { return __hip_atomic_load(p, __ATOMIC_RELAXED, __HIP_MEMORY_SCOPE_AGENT); }
DI unsigned xb_add(unsigned* p, unsigned v) { return __hip_atomic_fetch_add(p, v, __ATOMIC_RELAXED, __HIP_MEMORY_SCOPE_AGENT); }
DI unsigned xb_xcc_id() { return (unsigned)__builtin_amdgcn_s_getreg((3 << 11) | 20) & 0xFu; }
#define XB_SPIN(cond, bar) do { unsigned _sp = 0; while (cond) { __builtin_amdgcn_s_sleep(1); \
    if ((++_sp & 255u) == 0u) { if (xb_ld(&(bar)[XB_TMO])) break; if (_sp > XB_SPIN_CAP) { atomicAdd(&(bar)[XB_TMO], 1u); break; } } } } while (0)
struct XcdBarrier { unsigned* bar; unsigned x; volatile LAS unsigned* st; };
DI XcdBarrier xcd_barrier_post(unsigned* bar, volatile LAS unsigned* st, bool leader) {
  XcdBarrier b; b.bar = bar; b.x = xb_xcc_id(); b.st = st;
  if (leader) (void)xb_add(&bar[XB_XCNT(b.x)], 1u);
  return b;
}
DI void xcd_barrier_complete(unsigned* bar, unsigned x, unsigned& nloc, unsigned& nx) {
  const unsigned G = gridDim.x * gridDim.y * gridDim.z;
  unsigned sum, cnt, mine, sp = 0u;
  for (;;) {
    sum = 0u; cnt = 0u; mine = 0u;
#pragma unroll
    for (unsigned j = 0; j < 16; ++j) { const unsigned c = xb_ld(&bar[XB_XCNT(j)]); sum += c; cnt += (c > 0u) ? 1u : 0u; mine = (j == x) ? c : mine; }
    if (sum == G) break;
    __builtin_amdgcn_s_sleep(1);
    if ((++sp & 255u) == 0u) { if (xb_ld(&bar[XB_TMO])) break; if (sp > XB_SPIN_CAP) { atomicAdd(&bar[XB_TMO], 1u); break; } }
  }
  nloc = mine > 0u ? mine : 1u; nx = cnt > 0u ? cnt : 1u;
}
DI void xcd_barrier(const XcdBarrier& b, bool leader) {
  asm volatile("s_waitcnt vmcnt(0)" ::: "memory");
  __syncthreads();
  if (leader) {
    unsigned* bar = b.bar;
    __builtin_amdgcn_s_waitcnt(0);
    unsigned nloc = b.st[0], nx = b.st[1];
    if (nloc == 0u) { xcd_barrier_complete(bar, b.x, nloc, nx); b.st[0] = nloc; b.st[1] = nx; }
    const unsigned old = xb_add(&bar[XB_XSUB(b.x)], 1u);
    const unsigned gen = old / nloc;
    if (old + 1u == (gen + 1u) * nloc) {
      __builtin_amdgcn_fence(__ATOMIC_RELEASE, "agent");
      asm volatile("s_waitcnt vmcnt(0)" ::: "memory");
      const unsigned og = xb_add(&bar[XB_TOP], 1u);
      const unsigned tg = og / nx;
      if (og + 1u == (tg + 1u) * nx) xb_add(&bar[XB_TOPGEN], 1u);
      else XB_SPIN(xb_ld(&bar[XB_TOPGEN]) == tg, bar);
      __builtin_amdgcn_fence(__ATOMIC_ACQUIRE, "agent");
      xb_add(&bar[XB_XGEN(b.x)], 1u);
      asm volatile("s_waitcnt vmcnt(0)" ::: "memory");
    } else {
      XB_SPIN(xb_ld(&bar[XB_XGEN(b.x)]) == gen, bar);
      __builtin_amdgcn_fence(__ATOMIC_ACQUIRE, "agent");
      asm volatile("s_waitcnt vmcnt(0)" ::: "memory");
    }
  }
  __syncthreads();
}

namespace pg8 {
constexpr int BM = 256, BK = 64, HALF = 128, HTB = HALF * BK * 2, STAGE_BYTES = 8 * HTB, NXCD = 8, WGM = 8;
DI int lds_byte(int r, int c) { const int st = (r >> 4) * 2 + (c >> 5), rr = r & 15, cc = c & 31, ob = rr * 64 + cc * 2; return st * 1024 + (ob ^ (((ob >> 9) & 1) << 5)); }
DI void stage_rc(int b, int& R, int& C) { const int st = b / 1024, sb = b % 1024, swz = sb ^ (((sb >> 9) & 1) << 5); R = (st >> 1) * 16 + swz / 64; C = (st & 1) * 32 + (swz % 64) / 2; }
DI int perm32(int rho) { const int n = rho >> 4, i = rho & 15; return 8 * (i >> 2) + 4 * n + (i & 3); }
struct Unit { int pm, pn; };
struct Gemm { const bf16_t* A; const bf16_t* Bt; int M, N, K; };
struct StaticOrder {
  int nM, nN, nwg, G, c;
  DI void init(int M, int N, int G_, int c_) { nM = M / BM; nN = N / BM; nwg = nM * nN; G = G_; c = c_; }
  DI bool next(int i, Unit& u) const {
    const long L = (long)i * G + c; if (L >= nwg) return false;
    int wgid = (int)L; { const int q = nwg / NXCD, r = nwg % NXCD, xcd = wgid % NXCD, off = wgid / NXCD; wgid = (xcd < r ? xcd * (q + 1) : r * (q + 1) + (xcd - r) * q) + off; }
    const int nig = WGM * nN, gid = wgid / nig, fm = gid * WGM, gsz = (nM - fm) < WGM ? (nM - fm) : WGM;
    u.pm = fm + ((wgid % nig) % gsz); u.pn = (wgid % nig) / gsz; return true;
  }
};

struct SkewOrder : StaticOrder {
  int lo, skip;
  DI bool next(int i, Unit& u) const {
    const int full = nwg / G; int L;
    if (c < lo) { if (i >= full - skip) return false; L = i * G + c; }
    else if (i < full) L = i * G + c;
    else { const int p = (i - full) * (G - lo) + (c - lo), ns = skip * lo; if (p >= ns + nwg - full * G) return false;
      L = p < ns ? (full - skip) * G + p : full * G + (p - ns); }
    int wgid = L; { const int q = nwg / NXCD, r = nwg % NXCD, xcd = wgid % NXCD, off = wgid / NXCD; wgid = (xcd < r ? xcd * (q + 1) : r * (q + 1) + (xcd - r) * q) + off; }
    const int nig = WGM * nN, gid = wgid / nig, fm = gid * WGM, gsz = (nM - fm) < WGM ? (nM - fm) : WGM;
    u.pm = fm + ((wgid % nig) % gsz); u.pn = (wgid % nig) / gsz; return true;
  }
};
struct EpiBf16 {
  static constexpr bool PERM = true;
  bf16_t* O; int ldc; int nreal; int map; float scale;
  DI void operator()(const f32x4 (&acc)[2][2][4][2], const Unit& u, int wr, int wc, int fr, int fq) const {
    const int row0 = u.pm * BM + wr * 64 + fr; const int col0 = u.pn * BM + wc * 32 + 8 * fq;
    int ocol[2];
#pragma unroll
    for (int bj = 0; bj < 2; ++bj) { const int c = col0 + bj * HALF; ocol[bj] = map == 0 ? c : (map == 1 ? map8(c) : mapz(c)); }
#pragma unroll
    for (int ai = 0; ai < 2; ++ai)
#pragma unroll
      for (int m = 0; m < 4; ++m) { bf16_t* rowp = O + (size_t)(row0 + ai * HALF + m * 16) * ldc;
#pragma unroll
        for (int bj = 0; bj < 2; ++bj) { const f32x4 v0 = acc[ai][bj][m][0] * scale, v1 = acc[ai][bj][m][1] * scale;
          u32x4 w; w.x = cvtpk(v0[0], v0[1]); w.y = cvtpk(v0[2], v0[3]); w.z = cvtpk(v1[0], v1[1]); w.w = cvtpk(v1[2], v1[3]);
          if (col0 + bj * HALF < nreal) *(u32x4*)(rowp + ocol[bj]) = w; } }
  }
};
struct EpiResid {
  static constexpr bool PERM = false;
  const float* base_ctx; const float* base_lat; float* out_ctx; float* out_lat; const float* mod;   int row_off;
  DI void operator()(const f32x4 (&acc)[2][2][4][2], const Unit& u, int wr, int wc, int fr, int fq) const {
    const int grow0 = u.pm * BM + row_off;
    const bool isctx = grow0 < MCTX;
    const int lrow0 = isctx ? grow0 : grow0 - MCTX;
    const float* base = isctx ? base_ctx : base_lat; float* out = isctx ? out_ctx : out_lat;
    const int mrow = isctx ? 8 : (lrow0 >> 12);
    const float* gate = mod + mrow * 6144 + 4096;
    const int row0 = lrow0 + wr * 64 + fr, col0 = u.pn * BM + wc * 32 + 4 * fq;
    f32x4 gv[2][2];
#pragma unroll
    for (int bj = 0; bj < 2; ++bj)
#pragma unroll
      for (int n = 0; n < 2; ++n) gv[bj][n] = *(const f32x4*)(gate + col0 + bj * HALF + n * 16);
#pragma unroll
    for (int ai = 0; ai < 2; ++ai)
#pragma unroll
      for (int m = 0; m < 4; ++m) { const size_t ro = (size_t)(row0 + ai * HALF + m * 16) * DM + col0;
#pragma unroll
        for (int bj = 0; bj < 2; ++bj)
#pragma unroll
          for (int n = 0; n < 2; ++n) { const f32x4 bv = *(const f32x4*)(base + ro + bj * HALF + n * 16);
            *(f32x4*)(out + ro + bj * HALF + n * 16) = bv + gv[bj][n] * acc[ai][bj][m][n]; } }
  }
};

template <class Epi, class Sched, bool FP8 = false>
DI void gemm_phase(LAS unsigned char* lds, const Gemm g, const Sched& S, const Epi& E, int tid0) {
  int tid = tid0; asm volatile("" : "+v"(tid));
  const int wid = __builtin_amdgcn_readfirstlane(tid >> 6), lane = tid & 63, wr = wid >> 2, wc = wid & 3, fr = lane & 15, fq = lane >> 4;
  const int K = g.K, nt = FP8 ? K / 128 : K / BK;
  constexpr int ESZ = FP8 ? 1 : 2;
  unsigned voffA, voffB;
  { int R, C; stage_rc(tid * 16, R, C); const int Rb = Epi::PERM ? ((R & ~31) + perm32(R & 31)) : R;
    voffA = (unsigned)(R * K) * ESZ + C * 2u; voffB = (unsigned)(Rb * K) * ESZ + C * 2u; }
  const size_t rskip = (size_t)64 * K * ESZ;
  const size_t kstep = (size_t)(BK * 2);
  const size_t hstep = (size_t)HALF * K * ESZ;
  const size_t tstep = 2 * hstep;
  const unsigned ldsw = (unsigned)wid * 1024u;
  const int aoff = lds_byte(wr * 64 + fr, fq * 8), boff = lds_byte(wc * 32 + fr, fq * 8);
#define PG8_SA(b, h) (((b) * 2 + (h)) * HTB)
#define PG8_SB(b, h) ((4 + (b) * 2 + (h)) * HTB)
#define PG8_STAGE(bufoff, gbase, voff) do { _Pragma("unroll") for (int _i = 0; _i < 2; ++_i) \
    __builtin_amdgcn_global_load_lds((const unsigned*)((const char*)(gbase) + _i * rskip + (voff)), (LAS unsigned*)(lds + (bufoff) + ldsw + _i * 8192), 16, 0, 0); } while (0)
#define PG8_LD8(p) __builtin_bit_cast(v8i32, __builtin_shufflevector(*(const LAS u32x4*)(p), *(const LAS u32x4*)((p) + 1024), 0, 1, 2, 3, 4, 5, 6, 7))
#define PG8_LDA(dst, b, h) do { _Pragma("unroll") for (int m = 0; m < 4; ++m) { if constexpr (FP8) dst##8[m] = PG8_LD8(lds + PG8_SA(b, h) + aoff + m * 2048); \
    else { _Pragma("unroll") for (int k = 0; k < 2; ++k) dst[m][k] = *(const LAS bf16x8*)(lds + PG8_SA(b, h) + aoff + m * 2048 + k * 1024); } } } while (0)
#define PG8_LDB(dst, b, h) do { _Pragma("unroll") for (int n = 0; n < 2; ++n) { if constexpr (FP8) dst##8[n] = PG8_LD8(lds + PG8_SB(b, h) + boff + n * 2048); \
    else { _Pragma("unroll") for (int k = 0; k < 2; ++k) dst[n][k] = *(const LAS bf16x8*)(lds + PG8_SB(b, h) + boff + n * 2048 + k * 1024); } } } while (0)
#define PG8_MMA(ai, bj, At, Bt) do { __builtin_amdgcn_s_setprio(1); _Pragma("unroll") for (int m = 0; m < 4; ++m) _Pragma("unroll") for (int n = 0; n < 2; ++n) { \
    if constexpr (FP8) acc[ai][bj][m][n] = __builtin_amdgcn_mfma_scale_f32_16x16x128_f8f6f4(Bt##8[n], At##8[m], acc[ai][bj][m][n], 0, 0, 0, 0, 0, 0);     \
    else { _Pragma("unroll") for (int k = 0; k < 2; ++k) acc[ai][bj][m][n] = __builtin_amdgcn_mfma_f32_16x16x32_bf16(Bt[n][k], At[m][k], acc[ai][bj][m][n], 0, 0, 0); } } \
    __builtin_amdgcn_s_setprio(0); } while (0)
#define PG8_WAIT_V(n) asm volatile("s_waitcnt vmcnt(" #n ")" ::: "memory")
#define PG8_WAIT_L(n) asm volatile("s_waitcnt lgkmcnt(" #n ")" ::: "memory")
#define PG8_BAR __builtin_amdgcn_s_barrier()
#define PG8_SCHED __builtin_amdgcn_sched_barrier(0)
  Unit cur, nxt; int ui = 0;
  if (!S.next(0, cur)) return;
  f32x4 acc[2][2][4][2];
#pragma unroll
  for (int a = 0; a < 2; ++a)
#pragma unroll
    for (int b = 0; b < 2; ++b)
#pragma unroll
      for (int m = 0; m < 4; ++m)
#pragma unroll
        for (int n = 0; n < 2; ++n) acc[a][b][m][n] = (f32x4){0.f, 0.f, 0.f, 0.f};
  bf16x8 At[4][2], B0[2][2], B1[2][2]; v8i32 At8[4], B08[2], B18[2];
  const char* cA = (const char*)g.A + (size_t)cur.pm * tstep; const char* cB = (const char*)g.Bt + (size_t)cur.pn * tstep;
  PG8_STAGE(PG8_SB(0, 0), cB, voffB); PG8_STAGE(PG8_SA(0, 0), cA, voffA); PG8_STAGE(PG8_SB(0, 1), cB + hstep, voffB); PG8_STAGE(PG8_SA(0, 1), cA + hstep, voffA);
  if (wr == 1) PG8_BAR;
  PG8_WAIT_V(4); PG8_BAR;
  PG8_STAGE(PG8_SB(1, 0), cB + kstep, voffB); PG8_STAGE(PG8_SA(1, 0), cA + kstep, voffA); PG8_STAGE(PG8_SB(1, 1), cB + hstep + kstep, voffB);
  PG8_WAIT_V(6); PG8_BAR;
  for (;;) {
    const bool has_next = S.next(ui + 1, nxt);
    const char* nA = has_next ? (const char*)g.A + (size_t)nxt.pm * tstep : cA; const char* nB = has_next ? (const char*)g.Bt + (size_t)nxt.pn * tstep : cB;
    for (int t = 0; t < nt; t += 2) {
      const bool last = (t == nt - 2);
      const char* a1 = cA + (size_t)(t + 1) * kstep;
      const char* a2 = last ? nA : cA + (size_t)(t + 2) * kstep; const char* b2 = last ? nB : cB + (size_t)(t + 2) * kstep;
      const char* a3 = a2 + kstep; const char* b3 = b2 + kstep;
      PG8_LDB(B0, 0, 0); PG8_SCHED; PG8_LDA(At, 0, 0); PG8_STAGE(PG8_SA(1, 1), a1 + hstep, voffA);
      PG8_WAIT_L(8); PG8_BAR; PG8_WAIT_L(0); PG8_MMA(0, 0, At, B0); PG8_BAR; PG8_SCHED;
      PG8_LDB(B1, 0, 1); PG8_STAGE(PG8_SB(0, 0), b2, voffB);
      PG8_BAR; PG8_WAIT_L(0); PG8_MMA(0, 1, At, B1); PG8_BAR;
      PG8_LDA(At, 0, 1); PG8_STAGE(PG8_SA(0, 0), a2, voffA);
      PG8_BAR; PG8_WAIT_L(0); PG8_MMA(1, 0, At, B0); PG8_BAR; PG8_SCHED;
      PG8_STAGE(PG8_SB(0, 1), b2 + hstep, voffB);
      PG8_WAIT_V(6); PG8_BAR; PG8_MMA(1, 1, At, B1); PG8_BAR;
      PG8_LDB(B0, 1, 0); PG8_SCHED; PG8_LDA(At, 1, 0); PG8_STAGE(PG8_SA(0, 1), a2 + hstep, voffA);
      PG8_WAIT_L(8); PG8_BAR; PG8_WAIT_L(0); PG8_MMA(0, 0, At, B0); PG8_BAR; PG8_SCHED;
      PG8_LDB(B1, 1, 1); PG8_STAGE(PG8_SB(1, 0), b3, voffB);
      PG8_BAR; PG8_WAIT_L(0); PG8_MMA(0, 1, At, B1); PG8_BAR;
      PG8_LDA(At, 1, 1); PG8_STAGE(PG8_SA(1, 0), a3, voffA);
      PG8_BAR; PG8_WAIT_L(0); PG8_MMA(1, 0, At, B0); PG8_BAR; PG8_SCHED;
      PG8_STAGE(PG8_SB(1, 1), b3 + hstep, voffB);
      PG8_WAIT_V(6); PG8_BAR; PG8_MMA(1, 1, At, B1); PG8_BAR;
    }
    { const int l2 = lane_id(); E(acc, cur, wr, wc, l2 & 15, l2 >> 4); }
    if (!has_next) break;
#pragma unroll
    for (int a = 0; a < 2; ++a)
#pragma unroll
      for (int b = 0; b < 2; ++b)
#pragma unroll
        for (int m = 0; m < 4; ++m)
#pragma unroll
          for (int n = 0; n < 2; ++n) acc[a][b][m][n] = (f32x4){0.f, 0.f, 0.f, 0.f};
    cur = nxt; cA = nA; cB = nB; ++ui;
  }
  PG8_WAIT_V(0);
  if (wr == 0) PG8_BAR;
  PG8_BAR;
#undef PG8_SA
#undef PG8_SB
#undef PG8_STAGE
#undef PG8_LDA
#undef PG8_LDB
#undef PG8_LD8
#undef PG8_MMA
#undef PG8_WAIT_V
#undef PG8_WAIT_L
#undef PG8_BAR
#undef PG8_SCHED
}
}

struct AttnItem {
  const bf16_t* Q; int ldq;
  const bf16_t* K; int ldk;
  const bf16_t* K2; int ldk2;
  const bf16_t* V; int ldv;
  int ctxrow0, latrow0, NT;
  int mask, qpos0, kpos0;
  int has_sink; float sink_l2;
  int qrope; const float* ropeB;
  int qnorm; const float* qg;
  int mode; float lam, sub_scale; const float* subg; float* scratch;
  int probe;
  const bf16_t* Z; bf16_t* UX;
};

constexpr int QBLK = 32, KVBLK = 64;
constexpr float THR = 8.f;
#define SBAR() __builtin_amdgcn_sched_barrier(0)
DI int crow(int r, int hi) { return (r & 3) + 8 * (r >> 2) + 4 * hi; }
constexpr int VSUB = 576;
DI int v_st(int k, int c) { const int kk = (k & ~0xC) | ((k & 4) << 1) | ((k & 8) >> 1); return ((kk >> 3) * 4 + (c >> 5)) * VSUB + ((kk & 7) * 32 + (c & 31)) * 2; }
DI int v_rd_base(int lane) { return ((lane & 3) << 3) | (((lane >> 2) & 3) << 6) | (((lane >> 4) & 1) << 5) | (((lane >> 5) & 1) << 8); }
constexpr int v_rd_off(int d0, int ks, int half) { return (d0 + 8 * ks + 4 * half) * VSUB; }
template <int OFF> DI s16x4 tr_read(int vb) { s16x4 r; asm volatile("ds_read_b64_tr_b16 %0, %1 offset:%2" : "=&v"(r) : "v"(vb), "i"(OFF) : "memory"); return r; }
template <int D0> DI void pv_one(f32x16& od, int vb, bf16x8 pa0, bf16x8 pa1, bf16x8 pa2, bf16x8 pa3) {
  const s16x4 l0 = tr_read<v_rd_off(D0, 0, 0)>(vb), h0 = tr_read<v_rd_off(D0, 0, 1)>(vb), l1 = tr_read<v_rd_off(D0, 1, 0)>(vb), h1 = tr_read<v_rd_off(D0, 1, 1)>(vb);
  const s16x4 l2 = tr_read<v_rd_off(D0, 2, 0)>(vb), h2 = tr_read<v_rd_off(D0, 2, 1)>(vb), l3 = tr_read<v_rd_off(D0, 3, 0)>(vb), h3 = tr_read<v_rd_off(D0, 3, 1)>(vb);
  asm volatile("s_waitcnt lgkmcnt(0)" ::: "memory"); SBAR();
#define PK(L, H) (bf16x8){L[0], L[1], L[2], L[3], H[0], H[1], H[2], H[3]}
  od = __builtin_amdgcn_mfma_f32_32x32x16_bf16(pa0, PK(l0, h0), od, 0, 0, 0);
  od = __builtin_amdgcn_mfma_f32_32x32x16_bf16(pa1, PK(l1, h1), od, 0, 0, 0);
  od = __builtin_amdgcn_mfma_f32_32x32x16_bf16(pa2, PK(l2, h2), od, 0, 0, 0);
  od = __builtin_amdgcn_mfma_f32_32x32x16_bf16(pa3, PK(l3, h3), od, 0, 0, 0);
#undef PK
}
DI void pv_d0(f32x16* o, int vb, bf16x8 pa0, bf16x8 pa1, bf16x8 pa2, bf16x8 pa3) {
  pv_one<0>(o[0], vb, pa0, pa1, pa2, pa3); pv_one<1>(o[1], vb, pa0, pa1, pa2, pa3); pv_one<2>(o[2], vb, pa0, pa1, pa2, pa3); pv_one<3>(o[3], vb, pa0, pa1, pa2, pa3);
}

template <int DK> struct AttnCfg {
  static constexpr float SCALE = DK == 64 ? 0.125f : (DK == 128 ? 0.08838834764831845f : 0.07216878364870322f);
  static constexpr float C = SCALE * 1.4426950408889634f;
  static constexpr int KROW = DK * 2;
  static constexpr int SHM_V = 32 * VSUB, SHM_K = KVBLK * DK * 2;
};

template <int DK, bool MASKED> DI void partialSM(f32x16& p0, f32x16& p1, float& m_reg, float& mn, float& alpha, bool masked, int mb, int hi) {
  constexpr float C = AttnCfg<DK>::C, SCALE = AttnCfg<DK>::SCALE;
  if constexpr (MASKED) if (masked) {
#pragma unroll
    for (int r = 0; r < 16; ++r) { const int d0 = mb + crow(r, hi), d1 = d0 + 32;
      p0[r] = (d0 < -128 || d0 > 128) ? -1e30f : p0[r]; p1[r] = (d1 < -128 || d1 > 128) ? -1e30f : p1[r]; }
  }
  float pmax = p0[0];
#pragma unroll
  for (int r = 1; r < 16; ++r) pmax = fmaxf(pmax, p0[r]);
#pragma unroll
  for (int r = 0; r < 16; ++r) pmax = fmaxf(pmax, p1[r]);
  { auto rr = __builtin_amdgcn_permlane32_swap(__float_as_uint(pmax), __float_as_uint(pmax), false, false);
    pmax = fmaxf(__uint_as_float(rr[0]), __uint_as_float(rr[1])); }
  if (__builtin_expect(__all(pmax - m_reg <= THR / SCALE), 1)) { mn = m_reg; alpha = 1.f; }
  else { mn = fmaxf(m_reg, pmax); alpha = __builtin_amdgcn_exp2f((m_reg - mn) * C); m_reg = mn; }
  const float mnC = -mn * C;
#pragma unroll
  for (int r = 0; r < 16; ++r) p0[r] = fmaf(p0[r], C, mnC);
#pragma unroll
  for (int r = 0; r < 16; ++r) p1[r] = fmaf(p1[r], C, mnC);
#pragma unroll
  for (int r = 0; r < 16; ++r) p0[r] = __builtin_amdgcn_exp2f(p0[r]);
}
DI void finishSM(f32x16& p0, f32x16& p1, float alpha, float& l_reg, bf16x8& pa0, bf16x8& pa1, bf16x8& pa2, bf16x8& pa3) {
#pragma unroll
  for (int r = 0; r < 16; ++r) p1[r] = __builtin_amdgcn_exp2f(p1[r]);
  float ps = 0;
#pragma unroll
  for (int r = 0; r < 16; ++r) ps += p0[r];
#pragma unroll
  for (int r = 0; r < 16; ++r) ps += p1[r];
  { auto rr = __builtin_amdgcn_permlane32_swap(__float_as_uint(ps), __float_as_uint(ps), false, false);
    ps = __uint_as_float(rr[0]) + __uint_as_float(rr[1]); }
  l_reg = l_reg * alpha + ps;
#define PK4(P, BASE, OUT) do { unsigned a0 = cvtpk(P[BASE + 0], P[BASE + 1]), a1 = cvtpk(P[BASE + 2], P[BASE + 3]);   \
    unsigned b0 = cvtpk(P[BASE + 4], P[BASE + 5]), b1 = cvtpk(P[BASE + 6], P[BASE + 7]);                              \
    auto r0 = __builtin_amdgcn_permlane32_swap(a0, b0, false, false); auto r1 = __builtin_amdgcn_permlane32_swap(a1, b1, false, false); \
    u32x4 w = {r0[0], r1[0], r0[1], r1[1]}; OUT = *reinterpret_cast<bf16x8*>(&w); } while (0)
  PK4(p0, 0, pa0); PK4(p0, 8, pa1); PK4(p1, 0, pa2); PK4(p1, 8, pa3);
#undef PK4
}
template <int DK, int KB  > DI void qkt(f32x16& p0, f32x16& p1, const LAS char* const (&xo)[4], const LAS char* const (&xo1)[4], const bf16x8* qr, const LAS char* const (&xq)[4]) {
  p0 = f32x16{}; p1 = f32x16{};
  constexpr int KROW = AttnCfg<DK>::KROW;
#pragma unroll
  for (int d0 = 0; d0 < DK / 16; ++d0) { const int k = d0 >> 2, m = d0 & 3;
    const LAS char* kbp = (DK == 128) ? (k ? xo1[m] : xo[m]) + KB : xo[m] + (KB + k * 128);
    const bf16x8 b0 = *(const LAS bf16x8*)(kbp);
    const bf16x8 b1 = *(const LAS bf16x8*)(kbp + 32 * KROW);
    bf16x8 qv;
    if constexpr (DK == 192) { if (d0 >= 8) qv = *(const LAS bf16x8*)(xq[m]); else qv = qr[d0 < 8 ? d0 : 0]; }
    else qv = qr[d0];
    p0 = __builtin_amdgcn_mfma_f32_32x32x16_bf16(b0, qv, p0, 0, 0, 0);
    p1 = __builtin_amdgcn_mfma_f32_32x32x16_bf16(b1, qv, p1, 0, 0, 0); }
}

template <int DK, bool MASKED>
DI void attn_body(const AttnItem& it, char* lds, int tid0) {
  using Cfg = AttnCfg<DK>;
  constexpr int SHM_V = Cfg::SHM_V, SHM_K = Cfg::SHM_K, KROW = Cfg::KROW;
  constexpr float C = Cfg::C;
#define KSWZ(row) (DK == 128 ? (((((row) & 7) | ((((row) >> 4) & 1) << 3))) << 4) : ((((row) >> 1) & 7) << 4))
  int tid = tid0; asm volatile("" : "+v"(tid));
  const int wid = tid >> 6, lane = tid & 63, r32 = lane & 31, hi = lane >> 5;
  char* V_lds = lds; char* K_lds = lds + 2 * SHM_V;
  char* Qr_lds = lds + 2 * SHM_V + 2 * SHM_K + 2048;
  float* wsf = (float*)(lds + 2 * SHM_V + 2 * SHM_K) + wid * 64; float* li_l = wsf; float* al_l = wsf + 32;
  const int sr = tid >> 4, sc = (tid & 15) * 8, vst0 = v_st(sr, sc), vst1 = v_st(32 + sr, sc);
  const int kr8 = tid >> 3, kc8 = (tid & 7) * 8;
  const int vb0 = (int)(uintptr_t)V_lds + v_rd_base(lane);
  const LAS char* xo[4]; const LAS char* xo1[4]; const LAS char* xq[4];
#pragma unroll
  for (int m = 0; m < 4; ++m) { const int t = ((m * 32 + hi * 16) ^ (KSWZ(r32) & 0x70)); const int hb = (DK == 128) ? ((r32 >> 4) & 1) * 128 : 0;
    xo[m] = (const LAS char*)K_lds + (r32 * KROW + t + hb); xo1[m] = (const LAS char*)K_lds + (r32 * KROW + t + (128 - hb)); xq[m] = (const LAS char*)Qr_lds + ((wid * QBLK + r32) * 128 + t); }
  constexpr int SDEPTH = (DK == 192) ? 1 : 2;
  struct { bf16x8 vs0, vs1, ks0, ks1, ks2; } sr_[SDEPTH];
#define KTROW(j) (((j) < 4 ? it.ctxrow0 : it.latrow0) + (j) * KVBLK)
  const long voV0 = (long)sr * it.ldv + sc, voV1 = (long)(32 + sr) * it.ldv + sc;
  const long voK0 = DK == 64 ? (long)kr8 * it.ldk + kc8 : (long)sr * it.ldk + sc, voK1 = (long)(32 + sr) * it.ldk + sc;
  const long voK2 = DK == 192 ? (long)kr8 * it.ldk2 + kc8 : 0;
#define SLOAD(i, j) do { const long _r = KTROW(j); const bf16_t* _vb = it.V + _r * it.ldv; const bf16_t* _kb = it.K + _r * it.ldk; \
    sr_[i].vs0 = *reinterpret_cast<const bf16x8*>(_vb + voV0); sr_[i].vs1 = *reinterpret_cast<const bf16x8*>(_vb + voV1); \
    sr_[i].ks0 = *reinterpret_cast<const bf16x8*>(_kb + voK0); \
    if constexpr (DK != 64) { sr_[i].ks1 = *reinterpret_cast<const bf16x8*>(_kb + voK1); } \
    if constexpr (DK == 192) { sr_[i].ks2 = *reinterpret_cast<const bf16x8*>(it.K2 + _r * it.ldk2 + voK2); } } while (0)
  SLOAD(0, 0); if constexpr (SDEPTH == 2) SLOAD(1, 1);
  constexpr int NQR = (DK == 192 ? 128 : DK) / 16;
  float m_reg = -1e30f, l_reg = 0; f32x16 o[4] = {}; bf16x8 qr[NQR];
  const bf16_t* Qw = it.Q + (long)(wid * QBLK + r32) * it.ldq + hi * 8;
#pragma unroll
  for (int d0 = 0; d0 < NQR; ++d0) qr[d0] = *reinterpret_cast<const bf16x8*>(Qw + d0 * 16);
  if constexpr (DK == 128) {
    if (it.qnorm || it.qrope) {
      const int pos = it.qpos0 + wid * QBLK + r32, prow = pos >> 6, pcol = pos & 63;
      const float* cosH = it.ropeB - 4096; const float* sinH = cosH + 2048;
      float f[8][8];
#pragma unroll
      for (int d0 = 0; d0 < 8; ++d0) unpack8(__builtin_bit_cast(u32x4, qr[d0]), f[d0]);
      if (it.qnorm) { float ss = 0.f;
#pragma unroll
        for (int d0 = 0; d0 < 8; ++d0)
#pragma unroll
          for (int j = 0; j < 8; ++j) ss += f[d0][j] * f[d0][j];
        ss += shfl_xor_l(ss, 32, lane); const float rn = rsqrtf(ss * (1.f / 128.f) + EPS);
#pragma unroll
        for (int d0 = 0; d0 < 8; ++d0) { const f32x8 g = *(const f32x8*)(it.qg + d0 * 16 + hi * 8);
#pragma unroll
          for (int j = 0; j < 8; ++j) f[d0][j] *= rn * g[j]; } }
      if (it.qrope) {
#pragma unroll
        for (int pr = 0; pr < 2; ++pr)
#pragma unroll
          for (int q2 = 0; q2 < 2; ++q2) { const int dA = pr * 4 + q2, dB = dA + 2; const int p = pr ? pcol : prow;
            const f32x8 cs = *(const f32x8*)(cosH + p * 32 + q2 * 16 + hi * 8), sn = *(const f32x8*)(sinH + p * 32 + q2 * 16 + hi * 8);
#pragma unroll
            for (int j = 0; j < 8; ++j) { const float x = f[dA][j], y = f[dB][j]; f[dA][j] = x * cs[j] - y * sn[j]; f[dB][j] = y * cs[j] + x * sn[j]; } } }
#pragma unroll
      for (int d0 = 0; d0 < 8; ++d0) qr[d0] = __builtin_bit_cast(bf16x8, pack8(f[d0]));
    }
  }
  if constexpr (DK == 64) {
    if (it.qrope) {
      const int pos = it.qpos0 + wid * QBLK + r32, prow = pos >> 6, pcol = pos & 63;
#pragma unroll
      for (int pr = 0; pr < 2; ++pr) { const float* cs = it.ropeB + (pr ? pcol : prow) * 16 + hi * 8; const float* sn = cs + 1024;
        float x[8], y[8]; unpack8(__builtin_bit_cast(u32x4, qr[2 * pr]), x); unpack8(__builtin_bit_cast(u32x4, qr[2 * pr + 1]), y);
#pragma unroll
        for (int j = 0; j < 8; ++j) { const float cj = cs[j], sj = sn[j], nx = x[j] * cj - y[j] * sj, ny = y[j] * cj + x[j] * sj; x[j] = nx; y[j] = ny; }
        qr[2 * pr] = __builtin_bit_cast(bf16x8, pack8(x)); qr[2 * pr + 1] = __builtin_bit_cast(bf16x8, pack8(y)); }
    }
  }
  if (PROBE_UNIFORM && it.probe) {
#pragma unroll
    for (int d0 = 0; d0 < NQR; ++d0) qr[d0] = (bf16x8){0, 0, 0, 0, 0, 0, 0, 0}; }
  __syncthreads();
  if constexpr (DK == 192) {
    const int pos = it.qpos0 + wid * QBLK + r32, prow = pos >> 6, pcol = pos & 63;
    char* qrow = Qr_lds + (wid * QBLK + r32) * 128;
#pragma unroll
    for (int pr = 0; pr < 2; ++pr) {
      u32x4 wa = *reinterpret_cast<const u32x4*>(Qw + (8 + 2 * pr) * 16), wb = *reinterpret_cast<const u32x4*>(Qw + (9 + 2 * pr) * 16);
      if (it.qrope) {
        const float* cs = it.ropeB + (pr ? pcol : prow) * 16 + hi * 8; const float* sn = cs + 1024;
        float a[8], b[8]; unpack8(wa, a); unpack8(wb, b);
        float na[8], nb[8];
#pragma unroll
        for (int j = 0; j < 8; ++j) { const float cj = cs[j], sj = sn[j]; na[j] = a[j] * cj - b[j] * sj; nb[j] = b[j] * cj + a[j] * sj; }
        wa = pack8(na); wb = pack8(nb);
      }
      if (PROBE_UNIFORM && it.probe) { wa = (u32x4){0u, 0u, 0u, 0u}; wb = wa; }
      *(u32x4*)(qrow + ((((2 * pr) * 16 + hi * 8) * 2) ^ KSWZ(r32))) = wa;
      *(u32x4*)(qrow + ((((2 * pr + 1) * 16 + hi * 8) * 2) ^ KSWZ(r32))) = wb;
    }
  }
#define KSW(row, colB) ((row) * KROW + ((colB) ^ KSWZ(row)))
#define SWRITE(b, i) do { *(bf16x8*)(V_lds + (b) * SHM_V + vst0) = sr_[i].vs0; *(bf16x8*)(V_lds + (b) * SHM_V + vst1) = sr_[i].vs1; \
    if constexpr (DK == 64) { *(bf16x8*)(K_lds + (b) * SHM_K + KSW(kr8, kc8 * 2)) = sr_[i].ks0; } \
    else { *(bf16x8*)(K_lds + (b) * SHM_K + KSW(sr, sc * 2)) = sr_[i].ks0; *(bf16x8*)(K_lds + (b) * SHM_K + KSW(32 + sr, sc * 2)) = sr_[i].ks1; } \
    if constexpr (DK == 192) { *(bf16x8*)(K_lds + (b) * SHM_K + KSW(kr8, 256 + kc8 * 2)) = sr_[i].ks2; } } while (0)
#define SWAIT() do { if constexpr (DK == 64) asm volatile("s_waitcnt vmcnt(3)" ::: "memory"); else if constexpr (DK == 128) asm volatile("s_waitcnt vmcnt(4)" ::: "memory"); else asm volatile("s_waitcnt vmcnt(0)" ::: "memory"); } while (0)
#define RESC(a) do { if (__any((a) < 1.f)) { if (hi == 0) al_l[r32] = (a); asm volatile("s_waitcnt lgkmcnt(0)" ::: "memory"); \
    _Pragma("unroll") for (int d = 0; d < 4; ++d) _Pragma("unroll") for (int r = 0; r < 16; ++r) o[d][r] *= al_l[crow(r, hi)]; } } while (0)
#define MB(j) (it.kpos0 + ((j) - 4) * KVBLK - qpos)
  const int qpos = it.qpos0 + wid * QBLK + r32;
  const bool msk = MASKED && it.mask != 0;
  f32x16 pA0, pA1, pB0, pB1; float mnA, mnB, alA, alB; bf16x8 pa0, pa1, pa2, pa3; const int NT = it.NT;
  constexpr int SE = 0, SO = SDEPTH - 1;
  asm volatile("s_waitcnt vmcnt(0)" ::: "memory"); SWRITE(0, SE); __syncthreads();
  qkt<DK, 0>(pA0, pA1, xo, xo1, qr, xq); partialSM<DK, MASKED>(pA0, pA1, m_reg, mnA, alA, false, 0, hi);
  if constexpr (SDEPTH == 2) { if (2 < NT) SLOAD(SE, 2); } else { SLOAD(SO, 1); }
  SWAIT(); SWRITE(1, SO); __syncthreads();
  for (int j = 1; j + 1 < NT; j += 2) {
    SBAR(); qkt<DK, SHM_K>(pB0, pB1, xo, xo1, qr, xq);
    finishSM(pA0, pA1, alA, l_reg, pa0, pa1, pa2, pa3); SBAR();
    SLOAD(SO, j + SDEPTH); SBAR();
    pv_d0(o, vb0, pa0, pa1, pa2, pa3); partialSM<DK, MASKED>(pB0, pB1, m_reg, mnB, alB, msk && j >= 4, MB(j), hi);
    __syncthreads(); SWAIT(); SWRITE(0, SE);
    RESC(alB); __syncthreads();
    SBAR(); qkt<DK, 0>(pA0, pA1, xo, xo1, qr, xq);
    finishSM(pB0, pB1, alB, l_reg, pa0, pa1, pa2, pa3); SBAR();
    if (SDEPTH == 1 || j + 3 < NT) SLOAD(SE, j + 1 + SDEPTH); SBAR();
    pv_d0(o, vb0 + SHM_V, pa0, pa1, pa2, pa3); partialSM<DK, MASKED>(pA0, pA1, m_reg, mnA, alA, msk && (j + 1) >= 4, MB(j + 1), hi);
    __syncthreads(); SWAIT(); SWRITE(1, SO);
    RESC(alA); __syncthreads();
  }
  SBAR(); qkt<DK, SHM_K>(pB0, pB1, xo, xo1, qr, xq);
  finishSM(pA0, pA1, alA, l_reg, pa0, pa1, pa2, pa3); SBAR();
  pv_d0(o, vb0, pa0, pa1, pa2, pa3); partialSM<DK, MASKED>(pB0, pB1, m_reg, mnB, alB, msk && (NT - 1) >= 4, MB(NT - 1), hi);
  __syncthreads(); RESC(alB);
  finishSM(pB0, pB1, alB, l_reg, pa0, pa1, pa2, pa3); SBAR();
  pv_d0(o, vb0 + SHM_V, pa0, pa1, pa2, pa3);
  if (it.has_sink) l_reg += __builtin_amdgcn_exp2f(it.sink_l2 - m_reg * C);
  if (hi == 0) li_l[r32] = l_reg; asm volatile("s_waitcnt lgkmcnt(0)" ::: "memory");
  float rli[16];
#pragma unroll
  for (int r = 0; r < 16; ++r) rli[r] = __builtin_amdgcn_rcpf(li_l[crow(r, hi)]);
  if (it.mode == 1) {
    float* sp = it.scratch + (size_t)wid * 4096 + lane;
#pragma unroll
    for (int d0 = 0; d0 < 4; ++d0)
#pragma unroll
      for (int r = 0; r < 16; ++r) sp[(d0 * 16 + r) * 64] = o[d0][r] * rli[r];
  } else {
    float rn[16];
    if (it.mode == 2) {
      const float* sp = it.scratch + (size_t)wid * 4096 + lane;
#pragma unroll
      for (int r = 0; r < 16; ++r) { float ss = 0.f;
#pragma unroll
        for (int d0 = 0; d0 < 4; ++d0) { const float v = sp[(d0 * 16 + r) * 64] - it.lam * (o[d0][r] * rli[r]); o[d0][r] = v; ss += v * v; }
#pragma unroll
        for (int m = 16; m >= 1; m >>= 1) ss += shfl_xor_l(ss, m, lane);
        rn[r] = rsqrtf(ss * (1.f / 128.f) + EPS) * it.sub_scale; }
    } else {
#pragma unroll
      for (int r = 0; r < 16; ++r) rn[r] = rli[r];
    }
    __syncthreads();
    constexpr int RS = 272;
    char* stg = lds + wid * (QBLK * RS);
#pragma unroll
    for (int r = 0; r < 16; ++r) { const int row = crow(r, hi);
#pragma unroll
      for (int d0 = 0; d0 < 4; ++d0) *(bf16_t*)(stg + row * RS + (d0 * 32 + r32) * 2) = f2bf(o[d0][r] * rn[r]); }
    asm volatile("s_waitcnt lgkmcnt(0)" ::: "memory");
    { const int row = lane >> 1, cb = (lane & 1) * 64;
      const bf16_t* zrow = it.Z + (size_t)(wid * QBLK + row) * NIN + cb; bf16_t* urow = it.UX + (size_t)(wid * QBLK + row) * DM + cb;
      u32x4 zv[8];
#pragma unroll
      for (int c = 0; c < 8; ++c) zv[c] = *(const u32x4*)(zrow + c * 8);
#pragma unroll
      for (int c = 0; c < 8; ++c) { float v[8], z[8]; unpack8(*(const u32x4*)(stg + row * RS + (cb + c * 8) * 2), v); unpack8(zv[c], z);
        if (it.mode == 2) { const f32x8 g = *(const f32x8*)(it.subg + cb + c * 8);
#pragma unroll
          for (int j = 0; j < 8; ++j) v[j] *= g[j]; }
#pragma unroll
        for (int j = 0; j < 8; ++j) v[j] *= silu(z[j]);
        *(u32x4*)(urow + c * 8) = pack8(v); } }
  }
#undef KTROW
#undef KSWZ
#undef SLOAD
#undef KSW
#undef SWRITE
#undef SWAIT
#undef RESC
#undef MB
}

template <bool F8>
DI void p0_tr_wave(const float* src, int K, int N, int scol0, void* dstv, int Kp, int kt, int n0, int lane) {
  const int k0 = kt * 64;
  if (k0 < K && scol0 >= 0) {
    const float* sp = src + (size_t)k0 * N + scol0 + lane;
#pragma unroll
    for (int h = 0; h < 2; ++h) {
      float v[32];
#pragma unroll
      for (int j = 0; j < 32; ++j) v[j] = sp[(size_t)(h * 32 + j) * N];
      if constexpr (F8) { unsigned char* drow = (unsigned char*)dstv + (size_t)(n0 + lane) * Kp + k0 + h * 32;
#pragma unroll
        for (int q = 0; q < 2; ++q) { u32x4 w;
#pragma unroll
          for (int e = 0; e < 4; ++e) w[e] = cvt4_fp8(v[q * 16 + e * 4] * W8_SCALE, v[q * 16 + e * 4 + 1] * W8_SCALE, v[q * 16 + e * 4 + 2] * W8_SCALE, v[q * 16 + e * 4 + 3] * W8_SCALE);
          *(u32x4*)(drow + q * 16) = w; } }
      else { bf16_t* drow = (bf16_t*)dstv + (size_t)(n0 + lane) * Kp + k0 + h * 32;
#pragma unroll
        for (int q = 0; q < 4; ++q) *(u32x4*)(drow + q * 8) = pack8(&v[q * 8]); }
    }
  } else {
    if constexpr (F8) { unsigned char* drow = (unsigned char*)dstv + (size_t)(n0 + lane) * Kp + k0;
#pragma unroll
      for (int q = 0; q < 4; ++q) *(u32x4*)(drow + q * 16) = (u32x4){0u, 0u, 0u, 0u}; }
    else { bf16_t* drow = (bf16_t*)dstv + (size_t)(n0 + lane) * Kp + k0;
#pragma unroll
      for (int q = 0; q < 8; ++q) *(u32x4*)(drow + q * 8) = (u32x4){0u, 0u, 0u, 0u}; }
  }
}
DI void p0_weights(const Args& a, int l, int wv_i, int wv_n, int lane) {
  unsigned char* Wt_in = a.ws + WS_WIN; bf16_t* Wt_out = (bf16_t*)(a.ws + WS_WOUT); bf16_t* Wt_uq = (bf16_t*)(a.ws + WS_WUQ); bf16_t* Wt_ukv = (bf16_t*)(a.ws + WS_WUKV);
  constexpr int T_IN8 = 32 * 68, T_INZ = 32 * 32, T_OUT = 32 * 32, T_UQ = 8 * 12, T_UKV = 4 * 16, T_L = T_IN8 + T_INZ + T_OUT + T_UQ + T_UKV;
  for (int tt = wv_i; tt < T_L; tt += wv_n) {
    int t = tt;
    if (t < T_IN8) { const int n0 = (t % 68) * 64; p0_tr_wave<true>(a.in[I_WIN] + (size_t)l * DM * NIN, DM, NIN, n0 < N8 ? map8(n0) : -1, Wt_in + (size_t)l * SZ_WIN, DM, t / 68, n0, lane); }
    else if ((t -= T_IN8) < T_INZ) { const int n0 = (t % 32) * 64; p0_tr_wave<false>(a.in[I_WIN] + (size_t)l * DM * NIN, DM, NIN, mapz(n0), Wt_in + (size_t)l * SZ_WIN + SZ_WIN8, DM, t / 32, n0, lane); }
    else if ((t -= T_INZ) < T_OUT) { const int n0 = (t % 32) * 64; p0_tr_wave<false>(a.in[I_WOUT] + (size_t)l * DM * DM, DM, DM, n0, Wt_out + (size_t)l * DM * DM, DM, t / 32, n0, lane); }
    else if ((t -= T_OUT) < T_UQ) { const int n0 = (t % 12) * 64; p0_tr_wave<false>(a.in[I_WUQ] + (size_t)l * 448 * 768, 448, 768, n0, Wt_uq + (size_t)l * 768 * 512, 512, t / 12, n0, lane); }
    else { t -= T_UQ; const int n0 = (t % 16) * 64; p0_tr_wave<false>(a.in[I_WUKV] + (size_t)l * 128 * 1024, 128, 1024, n0, Wt_ukv + (size_t)l * 1024 * 256, 256, t / 16, n0, lane); }
  }
}
DI void p0_sincos(double a, float& c, float& s) {
  const double TWO_PI = 6.283185307179586476925;
  double k = __builtin_rint(a / TWO_PI); double x = a - k * TWO_PI;
  double x2 = x * x, ts = x, tc = 1.0, ss = x, cs = 1.0;
  for (int n = 1; n <= 16; ++n) { tc *= -x2 / (double)((2 * n - 1) * (2 * n)); cs += tc; ts *= -x2 / (double)((2 * n) * (2 * n + 1)); ss += ts; }
  c = (float)cs; s = (float)ss;
}
DI void p0_phase(const Args& a, char* lds, int tid0) {
  int tid = tid0; asm volatile("" : "+v"(tid));
  const int G = gridDim.x, wid = tid >> 6, lane = tid & 63;
  float* fl = (float*)lds;
  unsigned char* Wt_in = a.ws + WS_WIN; bf16_t* Wt_out = (bf16_t*)(a.ws + WS_WOUT); bf16_t* Wt_uq = (bf16_t*)(a.ws + WS_WUQ); bf16_t* Wt_ukv = (bf16_t*)(a.ws + WS_WUKV);
  float* MOD = (float*)(a.ws + WS_MOD);
  constexpr int N_MOD = 2 * 24 * 16;
  for (int itx = blockIdx.x; itx < N_MOD; itx += G) {
    const int l = itx / 384, r0 = itx % 384, jb = r0 >> 4, kc = r0 & 15;
    float* sm = fl; float* red = fl + 9 * 128;
    for (int idx = tid; idx < 9 * 128; idx += 512) { const int r = idx >> 7, k = idx & 127;
      const float v = (r < 8) ? a.in[I_C][r * DM + kc * 128 + k] : a.in[I_CCTX][kc * 128 + k]; sm[idx] = silu(v); }
    __syncthreads();
    f32x4 acc[9];
#pragma unroll
    for (int r = 0; r < 9; ++r) acc[r] = (f32x4){0.f, 0.f, 0.f, 0.f};
    const float* wp = a.in[I_WMOD] + (size_t)l * DM * 6144 + (size_t)(kc * 128 + wid * 16) * 6144 + jb * 256 + lane * 4;
#pragma unroll
    for (int kk = 0; kk < 16; ++kk) { const f32x4 wv = *(const f32x4*)(wp + (size_t)kk * 6144);
#pragma unroll
      for (int r = 0; r < 9; ++r) acc[r] += sm[r * 128 + wid * 16 + kk] * wv; }
#pragma unroll
    for (int r = 0; r < 9; ++r) *(f32x4*)(red + (wid * 9 + r) * 256 + lane * 4) = acc[r];
    __syncthreads();
    for (int idx = tid; idx < 9 * 256; idx += 512) { const int r = idx >> 8, cidx = idx & 255; float sum = 0.f;
#pragma unroll
      for (int w = 0; w < 8; ++w) sum += red[(w * 9 + r) * 256 + cidx];
      if (kc == 0) sum += a.in[I_BMOD][l * 6144 + jb * 256 + cidx];
      atomicAdd(MOD + (size_t)(l * 9 + r) * 6144 + jb * 256 + cidx, sum); }
    __syncthreads();
  }
  if (blockIdx.x == 0) {
    float* rope = (float*)(a.ws + WS_ROPE);
    for (int idx = tid; idx < 3072; idx += 512) {
      int pos, fi, nf; float* cdst; float* sdst;
      if (idx < 2048) { pos = idx >> 5; fi = idx & 31; nf = 32; cdst = rope + idx; sdst = rope + 2048 + idx; }
      else { const int i2 = idx - 2048; pos = i2 >> 4; fi = i2 & 15; nf = 16; cdst = rope + 4096 + i2; sdst = rope + 5120 + i2; }
      double f = 1.0; const int e = fi * (32 / nf); for (int q = 0; q < e; ++q) f *= 0.7498942093324559;
      float c, sn; p0_sincos((double)pos * f, c, sn); *cdst = c; *sdst = sn;
    }
  }
  p0_weights(a, 0, blockIdx.x * 8 + wid, G * 8, lane);
}

DI void prenorm_phase(const Args& a, int l, int tid0) {
  int tid = tid0; asm volatile("" : "+v"(tid));
  const int wid = tid >> 6, lane = tid & 63;
  const float* xs = l == 0 ? a.in[I_X] : a.out; const float* cs = l == 0 ? a.in[I_CTX] : (const float*)(a.ws + WS_CTX1);
  const float* g = a.in[I_NORMG] + l * DM; const float* MOD = (const float*)(a.ws + WS_MOD) + (size_t)l * 9 * 6144;
  bf16_t* H = (bf16_t*)(a.ws + WS_H); unsigned char* H8 = a.ws + WS_H8;
  const int nw = gridDim.x * 8, per = (MTOT + nw - 1) / nw, gw = blockIdx.x * 8 + wid;
  int row = gw * per; const int rend = (row + per < MTOT) ? row + per : MTOT;
  if (row >= rend) return;
  f32x4 A[8], Bv[8], va[8], vb[8]; int cur_m = -1;
#define PRE_LOAD(V, r) do { const float* _src = (r) < MCTX ? cs + (size_t)(r) * DM : xs + (size_t)((r) - MCTX) * DM; \
    _Pragma("unroll") for (int i = 0; i < 8; ++i) V[i] = *(const f32x4*)(_src + (i * 64 + lane) * 4); } while (0)
#define PRE_PROC(V, r) do { const int _m = (r) < MCTX ? 8 : (((r) - MCTX) >> 12); \
    if (_m != cur_m) { cur_m = _m; const float* mod = MOD + _m * 6144; \
      _Pragma("unroll") for (int i = 0; i < 8; ++i) { const int col = (i * 64 + lane) * 4; A[i] = *(const f32x4*)(g + col) * (*(const f32x4*)(mod + 2048 + col) + 1.f); Bv[i] = *(const f32x4*)(mod + col); } } \
    float ss = 0.f; \
    _Pragma("unroll") for (int i = 0; i < 8; ++i) ss += V[i][0] * V[i][0] + V[i][1] * V[i][1] + V[i][2] * V[i][2] + V[i][3] * V[i][3]; \
    ss = wave_sum(ss, lane); const float rstd = rsqrtf(ss * (1.f / DM) + EPS); \
    _Pragma("unroll") for (int i = 0; i < 8; ++i) { const int col = (i * 64 + lane) * 4; const f32x4 y = V[i] * rstd * A[i] + Bv[i]; \
      u32x2 w = {cvtpk(y[0], y[1]), cvtpk(y[2], y[3])}; *(u32x2*)(H + (size_t)(r) * DM + col) = w; \
      *(unsigned*)(H8 + (size_t)(r) * DM + col) = cvt4_fp8(y[0] * A8_SCALE, y[1] * A8_SCALE, y[2] * A8_SCALE, y[3] * A8_SCALE); } } while (0)
  { const int _m = row < MCTX ? 8 : ((row - MCTX) >> 12); cur_m = _m; const float* mod = MOD + _m * 6144;
#pragma unroll
    for (int i = 0; i < 8; ++i) { const int col = (i * 64 + lane) * 4; A[i] = *(const f32x4*)(g + col) * (*(const f32x4*)(mod + 2048 + col) + 1.f); Bv[i] = *(const f32x4*)(mod + col); } }
  PRE_LOAD(va, row);
  for (; row < rend; row += 2) {
    { const int rn = row + 1 < rend ? row + 1 : rend - 1; PRE_LOAD(vb, rn); }
    __builtin_amdgcn_sched_barrier(0);
    PRE_PROC(va, row);
    __builtin_amdgcn_sched_barrier(0);
    { const int rn = row + 2 < rend ? row + 2 : rend - 1; PRE_LOAD(va, rn); }
    __builtin_amdgcn_sched_barrier(0);
    if (row + 1 < rend) PRE_PROC(vb, row + 1);
    __builtin_amdgcn_sched_barrier(0);
  }
#undef PRE_LOAD
#undef PRE_PROC
}

DI void rope8(float* x, float* y, const f32x8 cs, const f32x8 sn) {
#pragma unroll
  for (int j = 0; j < 8; ++j) { const float nx = x[j] * cs[j] - y[j] * sn[j], ny = y[j] * cs[j] + x[j] * sn[j]; x[j] = nx; y[j] = ny; }
}
DI void post_phase(const Args& a, int l, int tid0) {
  int tid = tid0; asm volatile("" : "+v"(tid));
  const int wid = tid >> 6, lane = tid & 63;
  const float* rope = (const float*)(a.ws + WS_ROPE); const float* cosH = rope; const float* sinH = rope + 2048; const float* cosB = rope + 4096; const float* sinB = rope + 5120;
  bf16_t* PROJ = (bf16_t*)(a.ws + WS_PROJ); bf16_t* CQN = (bf16_t*)(a.ws + WS_CQN); bf16_t* CKVN = (bf16_t*)(a.ws + WS_CKVN);
  const float* cqg = a.in[I_CQG] + l * 448; const float* ckvg = a.in[I_CKVG] + l * 128; const float* dkg = a.in[I_DKG] + l * 128;
  const bool is128 = lane < 32;
  const int tA = lane & 7, cA = (tA < 4) ? tA : tA + 4, tB = lane & 3, cB = (tB < 2) ? tB : tB + 2;
  const int colL = is128 ? (lane < 16 ? C_AK : C_DK) + ((lane >> 3) & 1) * 128 + cA * 8 : C_BK + ((lane - 32) >> 2) * 64 + cB * 8;
  const int colH = colL + (is128 ? 32 : 16);
  const int cq_l = lane < 56 ? lane : 55, ck_l = lane < 16 ? lane : 15;
  f32x8 gdL, gdH, gcq, gck;
  { gdL = *(const f32x8*)(dkg + cA * 8); gdH = *(const f32x8*)(dkg + (cA + 4) * 8); gcq = *(const f32x8*)(cqg + cq_l * 8); gck = *(const f32x8*)(ckvg + ck_l * 8); }
  const int nw = gridDim.x * 8, per = (MTOT + nw - 1) / nw, gw = blockIdx.x * 8 + wid;
  const int r0 = gw * per, rend = (r0 + per < MTOT) ? r0 + per : MTOT;
  for (int row = r0; row < rend; ++row) {
    bf16_t* p = PROJ + (size_t)row * NIN;
    const bool lat = row >= MCTX; const int pos = lat ? ((row - MCTX) & 4095) : 0, prow = pos >> 6, pcol = pos & 63;
    const u32x4 uL = *(const u32x4*)(p + colL), uH = *(const u32x4*)(p + colH);
    const u32x4 kL = *(const u32x4*)(p + C_KR + cB * 8), kH = *(const u32x4*)(p + C_KR + (cB + 2) * 8);
    const u32x4 cq = *(const u32x4*)(p + C_CQ + cq_l * 8), ck = *(const u32x4*)(p + C_CKV + ck_l * 8);
    const int pH = (tA < 4) ? prow : pcol, pB = (tB < 2) ? prow : pcol;
    const float* csp = is128 ? cosH + pH * 32 + (tA & 3) * 8 : cosB + pB * 16 + (tB & 1) * 8;
    const f32x8 csU = *(const f32x8*)csp, snU = *(const f32x8*)(csp + (is128 ? 2048 : 1024));
    const f32x8 csB = *(const f32x8*)(cosB + pB * 16 + (tB & 1) * 8), snB = *(const f32x8*)(sinB + pB * 16 + (tB & 1) * 8);
    __builtin_amdgcn_sched_barrier(0);
    float x[8], y[8];
    { unpack8(uL, x); unpack8(uH, y); float ss = 0.f;
#pragma unroll
      for (int j = 0; j < 8; ++j) ss += x[j] * x[j] + y[j] * y[j];
      ss += shfl_xor_l(ss, 1, lane); ss += shfl_xor_l(ss, 2, lane); ss += shfl_xor_l(ss, 4, lane);
      const bool isd = lane >= 16 && lane < 32;
      const float rn = rsqrtf(ss * (1.f / 128.f) + EPS);
#pragma unroll
      for (int j = 0; j < 8; ++j) { x[j] = isd ? x[j] * rn * gdL[j] : x[j]; y[j] = isd ? y[j] * rn * gdH[j] : y[j]; }
      if (lat) rope8(x, y, csU, snU);
      if (lat || isd) { *(u32x4*)(p + colL) = pack8(x); *(u32x4*)(p + colH) = pack8(y); } }
    if (lat) { unpack8(kL, x); unpack8(kH, y); rope8(x, y, csB, snB);
      if (lane < 4) { *(u32x4*)(p + C_KR + cB * 8) = pack8(x); *(u32x4*)(p + C_KR + (cB + 2) * 8) = pack8(y); } }
    { unpack8(cq, x); float ss = 0.f;
#pragma unroll
      for (int j = 0; j < 8; ++j) ss += x[j] * x[j];
      ss = wave_sum(lane < 56 ? ss : 0.f, lane); const float rn = rsqrtf(ss * (1.f / 448.f) + EPS);
#pragma unroll
      for (int j = 0; j < 8; ++j) x[j] = lane < 56 ? x[j] * rn * gcq[j] : 0.f;
      *(u32x4*)(CQN + (size_t)row * 512 + lane * 8) = pack8(x); }
    { unpack8(ck, x); float ss = 0.f;
#pragma unroll
      for (int j = 0; j < 8; ++j) ss += x[j] * x[j];
      ss = wave_sum(lane < 16 ? ss : 0.f, lane); const float rn = rsqrtf(ss * (1.f / 128.f) + EPS);
#pragma unroll
      for (int j = 0; j < 8; ++j) x[j] = lane < 16 ? x[j] * rn * gck[j] : 0.f;
      if (lane < 32) *(u32x4*)(CKVN + (size_t)row * 256 + lane * 8) = pack8(x); }
  }
}

DI void attn_phase(const Args& a, int l, char* lds, int tid0) {
  const int G = gridDim.x, bx = blockIdx.x; const int vcu = (G % 8 == 0) ? (bx % 8) * (G / 8) + bx / 8 : bx;
  const int nitems = 2048 + (l == 0 ? 128 : 0);
  const bf16_t* PROJ = (const bf16_t*)(a.ws + WS_PROJ); const bf16_t* CQH = (const bf16_t*)(a.ws + WS_CQH); const bf16_t* CKVH = (const bf16_t*)(a.ws + WS_CKVH);
  bf16_t* UX = (bf16_t*)(a.ws + WS_H);
  const float* bl = a.in[I_LAMBDA] + l * 256; float s1 = 0.f, s2 = 0.f;
  for (int i = 0; i < 64; ++i) { s1 += bl[i] * bl[64 + i]; s2 += bl[128 + i] * bl[192 + i]; }
  const float lam_init = l == 0 ? 0.2f : 0.35550906759096934f;
  const float lam = expf(s1) - expf(s2) + lam_init;
  for (int L = vcu; L < nitems; L += G) {
    int type, b, h, qb; bool isctx;
    if (L < 2048) { type = L >> 9; const int r = L & 511; b = r >> 6; h = (r >> 4) & 3; qb = r & 15; isctx = false; }
    else { int r = L - 2048; type = r >> 5; r &= 31; b = r >> 2; h = r & 3; qb = 0; isctx = true; }
    const int qrow0 = isctx ? b * 256 : MCTX + b * SEQ + qb * 256;
    AttnItem it;
    it.ctxrow0 = b * 256; it.latrow0 = MCTX + b * SEQ - 256; it.NT = isctx ? 4 : 68;
    it.mask = 0; it.qpos0 = qb * 256; it.kpos0 = 0; it.has_sink = 0; it.sink_l2 = 0.f; it.qrope = isctx ? 0 : 1; it.qnorm = 0; it.qg = a.in[I_DQG] + l * 128; it.ropeB = (const float*)(a.ws + WS_ROPE) + 4096;
    it.mode = 0; it.lam = lam; it.sub_scale = 1.f - lam_init; it.subg = a.in[I_SUBLN] + l * 128; it.scratch = (float*)(a.ws + WS_DIFF) + (size_t)bx * 32768;
    it.K2 = nullptr; it.ldk2 = 0; it.probe = (PROBE_UNIFORM == 1 && type == 1) || (PROBE_UNIFORM == 2 && type == 2) || (PROBE_UNIFORM == 3 && type == 3);
    if (type == 0) {
      it.V = PROJ + C_BV + h * 128; it.ldv = NIN; it.ldq = NIN; it.ldk = NIN;
      it.Z = PROJ + (size_t)qrow0 * NIN + C_BZ + h * 128; it.UX = UX + (size_t)qrow0 * DM + 512 + h * 128;
      for (int c = 0; c < 2; ++c) {
        it.Q = PROJ + (size_t)qrow0 * NIN + C_BQ + (2 * h + c) * 64; it.K = PROJ + C_BK + (2 * h + c) * 64; it.mode = 1 + c;
        attn_body<64, false>(it, lds, tid0);
      }
    } else if (type == 1) {
      it.Q = CQH + (size_t)qrow0 * 768 + h * 192; it.ldq = 768; it.K = CKVH + h * 256; it.ldk = 1024; it.K2 = PROJ + C_KR; it.ldk2 = NIN;
      it.V = CKVH + h * 256 + 128; it.ldv = 1024;
      it.Z = PROJ + (size_t)qrow0 * NIN + C_CZ + h * 128; it.UX = UX + (size_t)qrow0 * DM + 1024 + h * 128;
      attn_body<192, false>(it, lds, tid0);
    } else if (type == 2) {
      it.Q = PROJ + (size_t)qrow0 * NIN + C_DQ + h * 128; it.ldq = NIN; it.K = PROJ + C_DK + (h >> 1) * 128; it.ldk = NIN; it.V = PROJ + C_DV + (h >> 1) * 128; it.ldv = NIN;
      it.Z = PROJ + (size_t)qrow0 * NIN + C_DZ + h * 128; it.UX = UX + (size_t)qrow0 * DM + 1536 + h * 128; it.qnorm = 1;
      attn_body<128, false>(it, lds, tid0);
    } else {
      it.Q = PROJ + (size_t)qrow0 * NIN + C_AQ + h * 128; it.ldq = NIN; it.K = PROJ + C_AK + (h >> 1) * 128; it.ldk = NIN; it.V = PROJ + C_AV + (h >> 1) * 128; it.ldv = NIN;
      it.Z = PROJ + (size_t)qrow0 * NIN + C_AZ + h * 128; it.UX = UX + (size_t)qrow0 * DM + h * 128;
      it.has_sink = 1; it.sink_l2 = a.in[I_SINK][l * 4 + h] * 1.4426950408889634f;
      if (!isctx) { const int i0 = qb * 256; const int ks = i0 - 128 < 0 ? 0 : i0 - 128; const int ke = i0 + 384 > SEQ ? SEQ : i0 + 384;
        it.NT = 4 + (ke - ks) / 64; it.latrow0 = MCTX + b * SEQ + ks - 256; it.mask = 1; it.kpos0 = ks; }
      if (isctx) attn_body<128, false>(it, lds, tid0); else attn_body<128, true>(it, lds, tid0);
    }
  }
}

DI void final_phase(const Args& a, int tid0) {
  int tid = tid0; asm volatile("" : "+v"(tid));
  const int wid = tid >> 6, lane = tid & 63; const float* g = a.in[I_FNG];
  const int nw = gridDim.x * 8, per = (MLAT + nw - 1) / nw, gw = blockIdx.x * 8 + wid;
  int row = gw * per; const int rend = (row + per < MLAT) ? row + per : MLAT;
  if (row >= rend) return;
  f32x4 gv[8], va[8], vb[8];
#pragma unroll
  for (int i = 0; i < 8; ++i) gv[i] = *(const f32x4*)(g + (i * 64 + lane) * 4);
#define FIN_LOAD(V, r) do { _Pragma("unroll") for (int i = 0; i < 8; ++i) V[i] = *(const f32x4*)(a.out + (size_t)(r) * DM + (i * 64 + lane) * 4); } while (0)
#define FIN_PROC(V, r) do { float ss = 0.f; \
    _Pragma("unroll") for (int i = 0; i < 8; ++i) ss += V[i][0] * V[i][0] + V[i][1] * V[i][1] + V[i][2] * V[i][2] + V[i][3] * V[i][3]; \
    ss = wave_sum(ss, lane); const float rstd = rsqrtf(ss * (1.f / DM) + EPS); \
    _Pragma("unroll") for (int i = 0; i < 8; ++i) *(f32x4*)(a.out + (size_t)(r) * DM + (i * 64 + lane) * 4) = V[i] * rstd * gv[i]; } while (0)
  FIN_LOAD(va, row);
  for (; row < rend; row += 2) {
    { const int rn = row + 1 < rend ? row + 1 : rend - 1; FIN_LOAD(vb, rn); }
    __builtin_amdgcn_sched_barrier(0);
    FIN_PROC(va, row);
    __builtin_amdgcn_sched_barrier(0);
    { const int rn = row + 2 < rend ? row + 2 : rend - 1; FIN_LOAD(va, rn); }
    __builtin_amdgcn_sched_barrier(0);
    if (row + 1 < rend) FIN_PROC(vb, row + 1);
    __builtin_amdgcn_sched_barrier(0);
  }
#undef FIN_LOAD
#undef FIN_PROC
}

constexpr int N_PHASES = 14;
__global__ void __launch_bounds__(512, 2) fwd_mega(Args a0) {
  const Args& a = a0;
  extern __shared__ __attribute__((aligned(16))) unsigned char lds[];
  const int lo = a.ph_lo, hi = a.ph_hi;
  volatile LAS unsigned* xst = (volatile LAS unsigned*)((LAS unsigned char*)lds + LDS_BYTES);
  const int wv = __builtin_amdgcn_readfirstlane((int)threadIdx.x >> 6);
#define TID() (wv * 64 + lane_id())
  if (TID() < 4) xst[TID()] = 0u;
  __syncthreads();
  XcdBarrier xbar; xbar.bar = (unsigned*)(a.ws + WS_BAR); xbar.x = 0; xbar.st = xst;
  if (hi - lo > 1) xbar = xcd_barrier_post((unsigned*)(a.ws + WS_BAR), xst, TID() == 0);
#define IN(k) (lo <= (k) && (k) < hi)
#define SEAM(k) do { if (IN(k) && IN((k) + 1)) xcd_barrier(xbar, TID() == 0); } while (0)
  if (hi > 1000) cg::this_grid().sync();
  if (IN(0)) p0_phase(a, (char*)lds, TID());
  SEAM(0);
  for (int l = 0; l < 2; ++l) {
    const int pb = 1 + 6 * l;
#define FRESH(b) Args b = a0; asm volatile("" : "+s"(b.ws), "+s"(b.out))
    if (IN(pb)) { FRESH(a); prenorm_phase(a, l, TID()); }
    SEAM(pb);
    if (IN(pb + 1)) { FRESH(a);
      { pg8::Gemm g{(const bf16_t*)(a.ws + WS_H8), (const bf16_t*)(a.ws + WS_WIN + (size_t)l * SZ_WIN), MTOT, N8P, DM};
        pg8::SkewOrder S; S.init(MTOT, N8P, gridDim.x, blockIdx.x); S.lo = ((MTOT / 256) * (DM / 256)) % gridDim.x; S.skip = (S.lo > 0 && S.lo < (int)gridDim.x && S.nwg / S.G >= 2) ? 1 : 0; if (S.skip == 0) S.lo = 0;
        pg8::EpiBf16 E{(bf16_t*)(a.ws + WS_PROJ), NIN, N8, 1, 1.f / (A8_SCALE * W8_SCALE)};
        pg8::gemm_phase<pg8::EpiBf16, pg8::SkewOrder, true>((LAS unsigned char*)lds, g, S, E, TID()); }
      { pg8::Gemm g{(const bf16_t*)(a.ws + WS_H), (const bf16_t*)(a.ws + WS_WIN + (size_t)l * SZ_WIN + SZ_WIN8), MTOT, DM, DM};
        pg8::StaticOrder S; S.init(MTOT, DM, gridDim.x, blockIdx.x);
        pg8::EpiBf16 E{(bf16_t*)(a.ws + WS_PROJ), NIN, DM, 2, 1.f};
        pg8::gemm_phase<pg8::EpiBf16, pg8::StaticOrder>((LAS unsigned char*)lds, g, S, E, TID()); }
    }
    SEAM(pb + 1);
    if (IN(pb + 2)) { FRESH(a); post_phase(a, l, TID()); }
    SEAM(pb + 2);
    if (IN(pb + 3)) { FRESH(a);
      { pg8::Gemm g{(const bf16_t*)(a.ws + WS_CQN), (const bf16_t*)(a.ws + WS_WUQ + (size_t)l * SZ_WUQ), MTOT, 768, 512};
        pg8::StaticOrder S; S.init(MTOT, 768, gridDim.x, blockIdx.x);
        pg8::EpiBf16 E{(bf16_t*)(a.ws + WS_CQH), 768, 768, 0, 1.f};
        pg8::gemm_phase<pg8::EpiBf16, pg8::StaticOrder>((LAS unsigned char*)lds, g, S, E, TID()); }
      { pg8::Gemm g{(const bf16_t*)(a.ws + WS_CKVN), (const bf16_t*)(a.ws + WS_WUKV + (size_t)l * SZ_WUKV), MTOT, 1024, 256};
        pg8::StaticOrder S; S.init(MTOT, 1024, gridDim.x, blockIdx.x);
        pg8::EpiBf16 E{(bf16_t*)(a.ws + WS_CKVH), 1024, 1024, 0, 1.f};
        pg8::gemm_phase<pg8::EpiBf16, pg8::StaticOrder>((LAS unsigned char*)lds, g, S, E, TID()); }
    }
    SEAM(pb + 3);
    if (IN(pb + 4)) { FRESH(a); attn_phase(a, l, (char*)lds, TID()); }
    SEAM(pb + 4);
    if (IN(pb + 5)) { FRESH(a);
      const int roff = l == 0 ? 0 : MCTX; const int M = MTOT - roff;
      pg8::Gemm g{(const bf16_t*)(a.ws + WS_H) + (size_t)roff * DM, (const bf16_t*)(a.ws + WS_WOUT + (size_t)l * SZ_WOUT), M, DM, DM};
      pg8::StaticOrder S; S.init(M, DM, gridDim.x, blockIdx.x);
      pg8::EpiResid E{a.in[I_CTX], l == 0 ? a.in[I_X] : (const float*)a.out, (float*)(a.ws + WS_CTX1), a.out, (const float*)(a.ws + WS_MOD) + (size_t)l * 9 * 6144, roff};
      pg8::gemm_phase<pg8::EpiResid, pg8::StaticOrder>((LAS unsigned char*)lds, g, S, E, TID());
      if (l == 0) {
        const int Gx = gridDim.x, extra = (MTOT / 256) * (DM / 256) % Gx, bxx = blockIdx.x;
        if (extra == 0) { const int t2 = TID(); p0_weights(a, 1, bxx * 8 + (t2 >> 6), Gx * 8, t2 & 63); }
        else if (bxx >= extra) { const int t2 = TID(); p0_weights(a, 1, (bxx - extra) * 8 + (t2 >> 6), (Gx - extra) * 8, t2 & 63); }
      }
    }
    SEAM(pb + 5);
  }
  if (IN(13)) final_phase(a, TID());
#undef IN
#undef SEAM
}

extern "C" void kernel_launch(void* const* d_in, const int* in_sizes, int n_in, void* d_out, int out_size, void* d_ws, size_t ws_size, hipStream_t stream) {
  static int grid = 0;
  if (grid == 0) {
    if (n_in != 19 || out_size != MLAT * DM || ws_size < WS_END) { fprintf(stderr, "kernel_launch: unexpected shapes (n_in %d out %d ws %zu, need %zu)\n", n_in, out_size, ws_size, (size_t)WS_END); grid = -1; return; }
    int dev = 0, cus = 0, per_cu = 0;
    hipGetDevice(&dev); hipDeviceGetAttribute(&cus, hipDeviceAttributeMultiprocessorCount, dev);
    if (hipFuncSetAttribute((const void*)fwd_mega, hipFuncAttributeMaxDynamicSharedMemorySize, LDS_BYTES + 16) != hipSuccess) { fprintf(stderr, "kernel_launch: hipFuncSetAttribute failed\n"); grid = -1; return; }
    if (hipOccupancyMaxActiveBlocksPerMultiprocessor(&per_cu, (const void*)fwd_mega, 512, LDS_BYTES + 16) != hipSuccess || per_cu < 1) { fprintf(stderr, "kernel_launch: occupancy query gave %d\n", per_cu); per_cu = 1; }
    (void)hipGetLastError();
    grid = cus * per_cu; if (grid > 256) grid = 256;
  }
  if (grid < 0) return;
  hipMemsetAsync((char*)d_ws + WS_BAR, 0, 16384 + SZ_MOD, stream);
  Args a{};
  for (int i = 0; i < 19; ++i) a.in[i] = (const float*)d_in[i];
  a.out = (float*)d_out; a.ws = (unsigned char*)d_ws;
#if COOP
  a.ph_lo = 0; a.ph_hi = N_PHASES;
  void* args[] = {&a};
  hipError_t e = hipLaunchCooperativeKernel((const void*)fwd_mega, dim3(grid), dim3(512), args, LDS_BYTES + 16, stream);
  if (e != hipSuccess) fprintf(stderr, "cooperative launch failed: %s (grid %d)\n", hipGetErrorString(e), grid);
#else
  for (int p = 0; p < N_PHASES; ++p) { a.ph_lo = p; a.ph_hi = p + 1; hipLaunchKernelGGL(fwd_mega, dim3(grid), dim3(512), LDS_BYTES + 16, stream, a); }
#endif
}
```

```cpp
#include <hip/hip_runtime.h>
#include <hip/hip_cooperative_groups.h>
#include <cstdio>
namespace cg = cooperative_groups;

#ifndef PROBE_UNIFORM
#define PROBE_UNIFORM 0
#endif
#ifndef DUP_ATTN
#define DUP_ATTN 0
#endif
#ifndef DUP_GEMM
#define DUP_GEMM 0
#endif
#ifndef DUP_MISC
#define DUP_MISC 0
#endif
#ifndef PROBE_FP8
#define PROBE_FP8 0
#endif
#ifndef COOP
#define COOP 1
#endif

#define DI __device__ __forceinline__
#define LAS __attribute__((address_space(3)))
typedef unsigned short bf16_t;
typedef short bf16x8 __attribute__((ext_vector_type(8)));
typedef short s16x4 __attribute__((ext_vector_type(4)));
typedef float f32x4 __attribute__((ext_vector_type(4)));
typedef float f32x8 __attribute__((ext_vector_type(8)));
typedef float f32x16 __attribute__((ext_vector_type(16)));
typedef unsigned u32x4 __attribute__((ext_vector_type(4)));
typedef unsigned u32x2 __attribute__((ext_vector_type(2)));

constexpr int DM = 2048, NB = 8, SEQ = 4096, NCTX = 256;
constexpr int MCTX = NB * NCTX;
constexpr int MLAT = NB * SEQ;
constexpr int MTOT = MCTX + MLAT;
constexpr int NIN = 6272, NINP = 6400;
constexpr float EPS = 1e-6f;
constexpr int C_AQ = 0, C_AK = 512, C_AV = 768, C_AZ = 1024, C_BQ = 1536, C_BK = 2048, C_BV = 2560, C_BZ = 3072;
constexpr int C_CQ = 3584, C_CKV = 4032, C_KR = 4160, C_CZ = 4224, C_DQ = 4736, C_DK = 5248, C_DV = 5504, C_DZ = 5760;
static_assert(C_DZ + 512 == NIN, "cols");

constexpr size_t al256(size_t x) { return (x + 255) / 256 * 256; }
constexpr int N8 = 4224, N8P = 4352;
constexpr size_t SZ_WIN8 = (size_t)N8P * DM, SZ_WINZ = (size_t)DM * DM * 2;
constexpr size_t SZ_WIN = SZ_WIN8 + SZ_WINZ, SZ_WOUT = (size_t)DM * DM * 2, SZ_WUQ = (size_t)768 * 512 * 2, SZ_WUKV = (size_t)1024 * 256 * 2;
constexpr size_t WS_WIN = 0;
constexpr size_t WS_WOUT = WS_WIN + 2 * SZ_WIN;
constexpr size_t WS_WUQ = WS_WOUT + 2 * SZ_WOUT;
constexpr size_t WS_WUKV = WS_WUQ + 2 * SZ_WUQ;
constexpr size_t WS_BAR = WS_WUKV + 2 * SZ_WUKV;
constexpr size_t WS_MOD = WS_BAR + 16384;
constexpr size_t SZ_MOD = (size_t)2 * 9 * 6144 * 4;
constexpr size_t WS_ROPE = al256(WS_MOD + SZ_MOD);
constexpr size_t WS_H = al256(WS_ROPE + 6144 * 4);
constexpr size_t WS_PROJ = WS_H + (size_t)MTOT * DM * 2;
constexpr size_t WS_CQN = WS_PROJ + (size_t)MTOT * NIN * 2;
constexpr size_t WS_CKVN = WS_CQN + (size_t)MTOT * 512 * 2;
constexpr size_t WS_CQH = WS_CKVN + (size_t)MTOT * 256 * 2;
constexpr size_t WS_CKVH = WS_CQH + (size_t)MTOT * 768 * 2;
constexpr size_t WS_CTX1 = WS_CKVH + (size_t)MTOT * 1024 * 2;
constexpr size_t WS_DIFF = WS_CTX1 + (size_t)MCTX * DM * 4;
constexpr size_t WS_H8 = WS_DIFF + (size_t)256 * 32768 * 4;
constexpr size_t WS_END = WS_H8 + (size_t)MTOT * DM;

constexpr int LDS_BYTES = 131072;

struct Args { const float* in[19]; float* out; unsigned char* ws; int ph_lo, ph_hi; };
enum { I_X = 0, I_C, I_CTX, I_CCTX, I_WMOD, I_BMOD, I_NORMG, I_WIN, I_CQG, I_CKVG, I_WUQ, I_WUKV, I_DQG, I_DKG, I_SINK, I_LAMBDA, I_SUBLN, I_WOUT, I_FNG };

DI float bf2f(bf16_t b) { return __uint_as_float(((unsigned)b) << 16); }
DI unsigned cvtpk(float lo, float hi) { unsigned r; asm volatile("v_cvt_pk_bf16_f32 %0, %1, %2" : "=v"(r) : "v"(lo), "v"(hi)); return r; }
DI bf16_t f2bf(float x) { return (bf16_t)(cvtpk(x, x) & 0xffffu); }
DI void unpack8(u32x4 w, float* f) {
#pragma unroll
  for (int i = 0; i < 4; ++i) { f[2 * i] = __uint_as_float(w[i] << 16); f[2 * i + 1] = __uint_as_float(w[i] & 0xffff0000u); }
}
DI u32x4 pack8(const float* f) { u32x4 w = {cvtpk(f[0], f[1]), cvtpk(f[2], f[3]), cvtpk(f[4], f[5]), cvtpk(f[6], f[7])}; return w; }
typedef int v8i32 __attribute__((ext_vector_type(8)));
DI int lane_id() { int l; asm volatile("v_mbcnt_lo_u32_b32 %0, -1, 0\n\tv_mbcnt_hi_u32_b32 %0, -1, %0" : "=v"(l)); return l; }
DI unsigned cvt4_fp8(float a, float b, float c, float d) { int w = __builtin_amdgcn_cvt_pk_fp8_f32(a, b, 0, false); w = __builtin_amdgcn_cvt_pk_fp8_f32(c, d, w, true); return (unsigned)w; }
constexpr float A8_SCALE = 4.f, W8_SCALE = 32.f;
DI int map8(int n8) { return n8 < 1024 ? n8 : (n8 < 2560 ? n8 + 512 : (n8 < 3200 ? n8 + 1024 : n8 + 1536)); }
DI int mapz(int nz) { const int sg = nz >> 9; const int zb = sg == 0 ? C_AZ : (sg == 1 ? C_BZ : (sg == 2 ? C_CZ : C_DZ)); return zb + (nz & 511); }
DI float shfl_xor_l(float v, int m, int lane) { return __int_as_float(__builtin_amdgcn_ds_bpermute((lane ^ m) << 2, __float_as_int(v))); }
DI float wave_sum(float v, int lane) {
#pragma unroll
  for (int m = 32; m >= 1; m >>= 1) v += shfl_xor_l(v, m, lane);
  return v;
}
DI float silu(float z) { return z / (1.f + __expf(-z)); }


#define XB_TMO      128
#define XB_XCNT(j)  (256  + 64 * (j))
#define XB_XSUB(j)  (1280 + 64 * (j))
#define XB_XGEN(j)  (2304 + 64 * (j))
#define XB_TOP      3328
#define XB_TOPGEN   3392
#define XCD_BAR_WORDS 3456
#define XB_SPIN_CAP (1u << 22)
DI unsigned xb_ld(unsigned* p)              { return __hip_atomic_load(p, __ATOMIC_RELAXED, __HIP_MEMORY_SCOPE_AGENT); }
DI unsigned xb_add(unsigned* p, unsigned v) { return __hip_atomic_fetch_add(p, v, __ATOMIC_RELAXED, __HIP_MEMORY_SCOPE_AGENT); }
DI unsigned xb_xcc_id() { return (unsigned)__builtin_amdgcn_s_getreg((3 << 11) | 20) & 0xFu; }
#define XB_SPIN(cond, bar) do { unsigned _sp = 0; while (cond) { __builtin_amdgcn_s_sleep(1); \
    if ((++_sp & 255u) == 0u) { if (xb_ld(&(bar)[XB_TMO])) break; if (_sp > XB_SPIN_CAP) { atomicAdd(&(bar)[XB_TMO], 1u); break; } } } } while (0)
struct XcdBarrier { unsigned* bar; unsigned x; volatile LAS unsigned* st; };
DI XcdBarrier xcd_barrier_post(unsigned* bar, volatile LAS unsigned* st, bool leader) {
  XcdBarrier b; b.bar = bar; b.x = xb_xcc_id(); b.st = st;
  if (leader) (void)xb_add(&bar[XB_XCNT(b.x)], 1u);
  return b;
}
DI void xcd_barrier_complete(unsigned* bar, unsigned x, unsigned& nloc, unsigned& nx) {
  const unsigned G = gridDim.x * gridDim.y * gridDim.z;
  unsigned sum, cnt, mine, sp = 0u;
  for (;;) {
    sum = 0u; cnt = 0u; mine = 0u;
#pragma unroll
    for (unsigned j = 0; j < 16; ++j) { const unsigned c = xb_ld(&bar[XB_XCNT(j)]); sum += c; cnt += (c > 0u) ? 1u : 0u; mine = (j == x) ? c : mine; }
    if (sum == G) break;
    __builtin_amdgcn_s_sleep(1);
    if ((++sp & 255u) == 0u) { if (xb_ld(&bar[XB_TMO])) break; if (sp > XB_SPIN_CAP) { atomicAdd(&bar[XB_TMO], 1u); break; } }
  }
  nloc = mine > 0u ? mine : 1u; nx = cnt > 0u ? cnt : 1u;
}
DI void xcd_barrier(const XcdBarrier& b, bool leader) {
  asm volatile("s_waitcnt vmcnt(0)" ::: "memory");
  __syncthreads();
  if (leader) {
    unsigned* bar = b.bar;
    __builtin_amdgcn_s_waitcnt(0);
    unsigned nloc = b.st[0], nx = b.st[1];
    if (nloc == 0u) { xcd_barrier_complete(bar, b.x, nloc, nx); b.st[0] = nloc; b.st[1] = nx; }
    const unsigned old = xb_add(&bar[XB_XSUB(b.x)], 1u);
    const unsigned gen = old / nloc;
    if (old + 1u == (gen + 1u) * nloc) {
      __builtin_amdgcn_fence(__ATOMIC_RELEASE, "agent");
      asm volatile("s_waitcnt vmcnt(0)" ::: "memory");
      const unsigned og = xb_add(&bar[XB_TOP], 1u);
      const unsigned tg = og / nx;
      if (og + 1u == (tg + 1u) * nx) xb_add(&bar[XB_TOPGEN], 1u);
      else XB_SPIN(xb_ld(&bar[XB_TOPGEN]) == tg, bar);
      __builtin_amdgcn_fence(__ATOMIC_ACQUIRE, "agent");
      xb_add(&bar[XB_XGEN(b.x)], 1u);
      asm volatile("s_waitcnt vmcnt(0)" ::: "memory");
    } else {
      XB_SPIN(xb_ld(&bar[XB_XGEN(b.x)]) == gen, bar);
      __builtin_amdgcn_fence(__ATOMIC_ACQUIRE, "agent");
      asm volatile("s_waitcnt vmcnt(0)" ::: "memory");
    }
  }
  __syncthreads();
}

namespace pg8 {
constexpr int BM = 256, BK = 64, HALF = 128, HTB = HALF * BK * 2, STAGE_BYTES = 8 * HTB, NXCD = 8, WGM = 8;
DI int lds_byte(int r, int c) { const int st = (r >> 4) * 2 + (c >> 5), rr = r & 15, cc = c & 31, ob = rr * 64 + cc * 2; return st * 1024 + (ob ^ (((ob >> 9) & 1) << 5)); }
DI void stage_rc(int b, int& R, int& C) { const int st = b / 1024, sb = b % 1024, swz = sb ^ (((sb >> 9) & 1) << 5); R = (st >> 1) * 16 + swz / 64; C = (st & 1) * 32 + (swz % 64) / 2; }
DI int perm32(int rho) { const int n = rho >> 4, i = rho & 15; return 8 * (i >> 2) + 4 * n + (i & 3); }
struct Unit { int pm, pn; };
struct Gemm { const bf16_t* A; const bf16_t* Bt; int M, N, K; };
struct StaticOrder {
  int nM, nN, nwg, G, c;
  DI void init(int M, int N, int G_, int c_) { nM = M / BM; nN = N / BM; nwg = nM * nN; G = G_; c = c_; }
  DI bool next(int i, Unit& u) const {
    const long L = (long)i * G + c; if (L >= nwg) return false;
    int wgid = (int)L; { const int q = nwg / NXCD, r = nwg % NXCD, xcd = wgid % NXCD, off = wgid / NXCD; wgid = (xcd < r ? xcd * (q + 1) : r * (q + 1) + (xcd - r) * q) + off; }
    const int nig = WGM * nN, gid = wgid / nig, fm = gid * WGM, gsz = (nM - fm) < WGM ? (nM - fm) : WGM;
    u.pm = fm + ((wgid % nig) % gsz); u.pn = (wgid % nig) / gsz; return true;
  }
};

struct SkewOrder : StaticOrder {
  int lo, skip;
  DI bool next(int i, Unit& u) const {
    const int full = nwg / G; int L;
    if (c < lo) { if (i >= full - skip) return false; L = i * G + c; }
    else if (i < full) L = i * G + c;
    else { const int p = (i - full) * (G - lo) + (c - lo), ns = skip * lo; if (p >= ns + nwg - full * G) return false;
      L = p < ns ? (full - skip) * G + p : full * G + (p - ns); }
    int wgid = L; { const int q = nwg / NXCD, r = nwg % NXCD, xcd = wgid % NXCD, off = wgid / NXCD; wgid = (xcd < r ? xcd * (q + 1) : r * (q + 1) + (xcd - r) * q) + off; }
    const int nig = WGM * nN, gid = wgid / nig, fm = gid * WGM, gsz = (nM - fm) < WGM ? (nM - fm) : WGM;
    u.pm = fm + ((wgid % nig) % gsz); u.pn = (wgid % nig) / gsz; return true;
  }
};
struct EpiBf16 {
  static constexpr bool PERM = true;
  bf16_t* O; int ldc; int nreal; int map; float scale;
  DI void operator()(const f32x4 (&acc)[2][2][4][2], const Unit& u, int wr, int wc, int fr, int fq) const {
    const int row0 = u.pm * BM + wr * 64 + fr; const int col0 = u.pn * BM + wc * 32 + 8 * fq;
    int ocol[2];
#pragma unroll
    for (int bj = 0; bj < 2; ++bj) { const int c = col0 + bj * HALF; ocol[bj] = map == 0 ? c : (map == 1 ? map8(c) : mapz(c)); }
#pragma unroll
    for (int ai = 0; ai < 2; ++ai)
#pragma unroll
      for (int m = 0; m < 4; ++m) { bf16_t* rowp = O + (size_t)(row0 + ai * HALF + m * 16) * ldc;
#pragma unroll
        for (int bj = 0; bj < 2; ++bj) { const f32x4 v0 = acc[ai][bj][m][0] * scale, v1 = acc[ai][bj][m][1] * scale;
          u32x4 w; w.x = cvtpk(v0[0], v0[1]); w.y = cvtpk(v0[2], v0[3]); w.z = cvtpk(v1[0], v1[1]); w.w = cvtpk(v1[2], v1[3]);
          if (col0 + bj * HALF < nreal) *(u32x4*)(rowp + ocol[bj]) = w; } }
  }
};
struct EpiResid {
  static constexpr bool PERM = false;
  const float* base_ctx; const float* base_lat; float* out_ctx; float* out_lat; const float* mod;   int row_off;
  DI void operator()(const f32x4 (&acc)[2][2][4][2], const Unit& u, int wr, int wc, int fr, int fq) const {
    const int grow0 = u.pm * BM + row_off;
    const bool isctx = grow0 < MCTX;
    const int lrow0 = isctx ? grow0 : grow0 - MCTX;
    const float* base = isctx ? base_ctx : base_lat; float* out = isctx ? out_ctx : out_lat;
    const int mrow = isctx ? 8 : (lrow0 >> 12);
    const float* gate = mod + mrow * 6144 + 4096;
    const int row0 = lrow0 + wr * 64 + fr, col0 = u.pn * BM + wc * 32 + 4 * fq;
    f32x4 gv[2][2];
#pragma unroll
    for (int bj = 0; bj < 2; ++bj)
#pragma unroll
      for (int n = 0; n < 2; ++n) gv[bj][n] = *(const f32x4*)(gate + col0 + bj * HALF + n * 16);
#pragma unroll
    for (int ai = 0; ai < 2; ++ai)
#pragma unroll
      for (int m = 0; m < 4; ++m) { const size_t ro = (size_t)(row0 + ai * HALF + m * 16) * DM + col0;
#pragma unroll
        for (int bj = 0; bj < 2; ++bj)
#pragma unroll
          for (int n = 0; n < 2; ++n) { const f32x4 bv = *(const f32x4*)(base + ro + bj * HALF + n * 16);
            *(f32x4*)(out + ro + bj * HALF + n * 16) = bv + gv[bj][n] * acc[ai][bj][m][n]; } }
  }
};

template <class Epi, class Sched, bool FP8 = false>
DI void gemm_phase(LAS unsigned char* lds, const Gemm g, const Sched& S, const Epi& E, int tid0) {
  int tid = tid0; asm volatile("" : "+v"(tid));
  const int wid = __builtin_amdgcn_readfirstlane(tid >> 6), lane = tid & 63, wr = wid >> 2, wc = wid & 3, fr = lane & 15, fq = lane >> 4;
  const int K = g.K, nt = FP8 ? K / 128 : K / BK;
  constexpr int ESZ = FP8 ? 1 : 2;
  unsigned voffA, voffB;
  { int R, C; stage_rc(tid * 16, R, C); const int Rb = Epi::PERM ? ((R & ~31) + perm32(R & 31)) : R;
    voffA = (unsigned)(R * K) * ESZ + C * 2u; voffB = (unsigned)(Rb * K) * ESZ + C * 2u; }
  const size_t rskip = (size_t)64 * K * ESZ;
  const size_t kstep = (size_t)(BK * 2);
  const size_t hstep = (size_t)HALF * K * ESZ;
  const size_t tstep = 2 * hstep;
  const unsigned ldsw = (unsigned)wid * 1024u;
  const int aoff = lds_byte(wr * 64 + fr, fq * 8), boff = lds_byte(wc * 32 + fr, fq * 8);
#define PG8_SA(b, h) (((b) * 2 + (h)) * HTB)
#define PG8_SB(b, h) ((4 + (b) * 2 + (h)) * HTB)
#define PG8_STAGE(bufoff, gbase, voff) do { _Pragma("unroll") for (int _i = 0; _i < 2; ++_i) \
    __builtin_amdgcn_global_load_lds((const unsigned*)((const char*)(gbase) + _i * rskip + (voff)), (LAS unsigned*)(lds + (bufoff) + ldsw + _i * 8192), 16, 0, 0); } while (0)
#define PG8_LD8(p) __builtin_bit_cast(v8i32, __builtin_shufflevector(*(const LAS u32x4*)(p), *(const LAS u32x4*)((p) + 1024), 0, 1, 2, 3, 4, 5, 6, 7))
#define PG8_LDA(dst, b, h) do { _Pragma("unroll") for (int m = 0; m < 4; ++m) { if constexpr (FP8) dst##8[m] = PG8_LD8(lds + PG8_SA(b, h) + aoff + m * 2048); \
    else { _Pragma("unroll") for (int k = 0; k < 2; ++k) dst[m][k] = *(const LAS bf16x8*)(lds + PG8_SA(b, h) + aoff + m * 2048 + k * 1024); } } } while (0)
#define PG8_LDB(dst, b, h) do { _Pragma("unroll") for (int n = 0; n < 2; ++n) { if constexpr (FP8) dst##8[n] = PG8_LD8(lds + PG8_SB(b, h) + boff + n * 2048); \
    else { _Pragma("unroll") for (int k = 0; k < 2; ++k) dst[n][k] = *(const LAS bf16x8*)(lds + PG8_SB(b, h) + boff + n * 2048 + k * 1024); } } } while (0)
#define PG8_MMA(ai, bj, At, Bt) do { __builtin_amdgcn_s_setprio(1); _Pragma("unroll") for (int m = 0; m < 4; ++m) _Pragma("unroll") for (int n = 0; n < 2; ++n) { \
    if constexpr (FP8) acc[ai][bj][m][n] = __builtin_amdgcn_mfma_scale_f32_16x16x128_f8f6f4(Bt##8[n], At##8[m], acc[ai][bj][m][n], 0, 0, 0, 0, 0, 0);     \
    else { _Pragma("unroll") for (int k = 0; k < 2; ++k) acc[ai][bj][m][n] = __builtin_amdgcn_mfma_f32_16x16x32_bf16(Bt[n][k], At[m][k], acc[ai][bj][m][n], 0, 0, 0); } } \
    __builtin_amdgcn_s_setprio(0); } while (0)
#define PG8_WAIT_V(n) asm volatile("s_waitcnt vmcnt(" #n ")" ::: "memory")
#define PG8_WAIT_L(n) asm volatile("s_waitcnt lgkmcnt(" #n ")" ::: "memory")
#define PG8_BAR __builtin_amdgcn_s_barrier()
#define PG8_SCHED __builtin_amdgcn_sched_barrier(0)
  Unit cur, nxt; int ui = 0;
  if (!S.next(0, cur)) return;
  f32x4 acc[2][2][4][2];
#pragma unroll
  for (int a = 0; a < 2; ++a)
#pragma unroll
    for (int b = 0; b < 2; ++b)
#pragma unroll
      for (int m = 0; m < 4; ++m)
#pragma unroll
        for (int n = 0; n < 2; ++n) acc[a][b][m][n] = (f32x4){0.f, 0.f, 0.f, 0.f};
  bf16x8 At[4][2], B0[2][2], B1[2][2]; v8i32 At8[4], B08[2], B18[2];
  const char* cA = (const char*)g.A + (size_t)cur.pm * tstep; const char* cB = (const char*)g.Bt + (size_t)cur.pn * tstep;
  PG8_STAGE(PG8_SB(0, 0), cB, voffB); PG8_STAGE(PG8_SA(0, 0), cA, voffA); PG8_STAGE(PG8_SB(0, 1), cB + hstep, voffB); PG8_STAGE(PG8_SA(0, 1), cA + hstep, voffA);
  if (wr == 1) PG8_BAR;
  PG8_WAIT_V(4); PG8_BAR;
  PG8_STAGE(PG8_SB(1, 0), cB + kstep, voffB); PG8_STAGE(PG8_SA(1, 0), cA + kstep, voffA); PG8_STAGE(PG8_SB(1, 1), cB + hstep + kstep, voffB);
  PG8_WAIT_V(6); PG8_BAR;
  for (;;) {
    const bool has_next = S.next(ui + 1, nxt);
    const char* nA = has_next ? (const char*)g.A + (size_t)nxt.pm * tstep : cA; const char* nB = has_next ? (const char*)g.Bt + (size_t)nxt.pn * tstep : cB;
    for (int t = 0; t < nt; t += 2) {
      const bool last = (t == nt - 2);
      const char* a1 = cA + (size_t)(t + 1) * kstep;
      const char* a2 = last ? nA : cA + (size_t)(t + 2) * kstep; const char* b2 = last ? nB : cB + (size_t)(t + 2) * kstep;
      const char* a3 = a2 + kstep; const char* b3 = b2 + kstep;
      PG8_LDB(B0, 0, 0); PG8_SCHED; PG8_LDA(At, 0, 0); PG8_STAGE(PG8_SA(1, 1), a1 + hstep, voffA);
      PG8_WAIT_L(8); PG8_BAR; PG8_WAIT_L(0); PG8_MMA(0, 0, At, B0); PG8_BAR; PG8_SCHED;
      PG8_LDB(B1, 0, 1); PG8_STAGE(PG8_SB(0, 0), b2, voffB);
      PG8_BAR; PG8_WAIT_L(0); PG8_MMA(0, 1, At, B1); PG8_BAR;
      PG8_LDA(At, 0, 1); PG8_STAGE(PG8_SA(0, 0), a2, voffA);
      PG8_BAR; PG8_WAIT_L(0); PG8_MMA(1, 0, At, B0); PG8_BAR; PG8_SCHED;
      PG8_STAGE(PG8_SB(0, 1), b2 + hstep, voffB);
      PG8_WAIT_V(6); PG8_BAR; PG8_MMA(1, 1, At, B1); PG8_BAR;
      PG8_LDB(B0, 1, 0); PG8_SCHED; PG8_LDA(At, 1, 0); PG8_STAGE(PG8_SA(0, 1), a2 + hstep, voffA);
      PG8_WAIT_L(8); PG8_BAR; PG8_WAIT_L(0); PG8_MMA(0, 0, At, B0); PG8_BAR; PG8_SCHED;
      PG8_LDB(B1, 1, 1); PG8_STAGE(PG8_SB(1, 0), b3, voffB);
      PG8_BAR; PG8_WAIT_L(0); PG8_MMA(0, 1, At, B1); PG8_BAR;
      PG8_LDA(At, 1, 1); PG8_STAGE(PG8_SA(1, 0), a3, voffA);
      PG8_BAR; PG8_WAIT_L(0); PG8_MMA(1, 0, At, B0); PG8_BAR; PG8_SCHED;
      PG8_STAGE(PG8_SB(1, 1), b3 + hstep, voffB);
      PG8_WAIT_V(6); PG8_BAR; PG8_MMA(1, 1, At, B1); PG8_BAR;
    }
    { const int l2 = lane_id(); E(acc, cur, wr, wc, l2 & 15, l2 >> 4); }
    if (!has_next) break;
#pragma unroll
    for (int a = 0; a < 2; ++a)
#pragma unroll
      for (int b = 0; b < 2; ++b)
#pragma unroll
        for (int m = 0; m < 4; ++m)
#pragma unroll
          for (int n = 0; n < 2; ++n) acc[a][b][m][n] = (f32x4){0.f, 0.f, 0.f, 0.f};
    cur = nxt; cA = nA; cB = nB; ++ui;
  }
  PG8_WAIT_V(0);
  if (wr == 0) PG8_BAR;
  PG8_BAR;
#undef PG8_SA
#undef PG8_SB
#undef PG8_STAGE
#undef PG8_LDA
#undef PG8_LDB
#undef PG8_LD8
#undef PG8_MMA
#undef PG8_WAIT_V
#undef PG8_WAIT_L
#undef PG8_BAR
#undef PG8_SCHED
}
}

struct AttnItem {
  const bf16_t* Q; int ldq;
  const bf16_t* K; int ldk;
  const bf16_t* K2; int ldk2;
  const bf16_t* V; int ldv;
  int ctxrow0, latrow0, NT;
  int mask, qpos0, kpos0;
  int has_sink; float sink_l2;
  int qrope; const float* ropeB;
  int qnorm; const float* qg;
  int mode; float lam, sub_scale; const float* subg; float* scratch;
  int probe;
  const bf16_t* Z; bf16_t* UX;
};

constexpr int QBLK = 32, KVBLK = 64;
constexpr float THR = 8.f;
#define SBAR() __builtin_amdgcn_sched_barrier(0)
DI int crow(int r, int hi) { return (r & 3) + 8 * (r >> 2) + 4 * hi; }
DI int v_st(int k, int c) { const int kk = (k & ~0xC) | ((k & 4) << 1) | ((k & 8) >> 1); return ((kk >> 3) * 4 + (c >> 5)) * 512 + ((kk & 7) * 32 + (c & 31)) * 2; }
DI int v_rd_base(int lane) { return ((lane & 3) << 3) | (((lane >> 2) & 3) << 6) | (((lane >> 4) & 1) << 5) | (((lane >> 5) & 1) << 8); }
constexpr int v_rd_off(int d0, int ks, int half) { return d0 * 512 + ks * 4096 + half * 2048; }
template <int OFF> DI s16x4 tr_read(int vb) { s16x4 r; asm volatile("ds_read_b64_tr_b16 %0, %1 offset:%2" : "=&v"(r) : "v"(vb), "i"(OFF) : "memory"); return r; }
template <int D0> DI void pv_one(f32x16& od, int vb, bf16x8 pa0, bf16x8 pa1, bf16x8 pa2, bf16x8 pa3) {
  const s16x4 l0 = tr_read<v_rd_off(D0, 0, 0)>(vb), h0 = tr_read<v_rd_off(D0, 0, 1)>(vb), l1 = tr_read<v_rd_off(D0, 1, 0)>(vb), h1 = tr_read<v_rd_off(D0, 1, 1)>(vb);
  const s16x4 l2 = tr_read<v_rd_off(D0, 2, 0)>(vb), h2 = tr_read<v_rd_off(D0, 2, 1)>(vb), l3 = tr_read<v_rd_off(D0, 3, 0)>(vb), h3 = tr_read<v_rd_off(D0, 3, 1)>(vb);
  asm volatile("s_waitcnt lgkmcnt(0)" ::: "memory"); SBAR();
#define PK(L, H) (bf16x8){L[0], L[1], L[2], L[3], H[0], H[1], H[2], H[3]}
  od = __builtin_amdgcn_mfma_f32_32x32x16_bf16(pa0, PK(l0, h0), od, 0, 0, 0);
  od = __builtin_amdgcn_mfma_f32_32x32x16_bf16(pa1, PK(l1, h1), od, 0, 0, 0);
  od = __builtin_amdgcn_mfma_f32_32x32x16_bf16(pa2, PK(l2, h2), od, 0, 0, 0);
  od = __builtin_amdgcn_mfma_f32_32x32x16_bf16(pa3, PK(l3, h3), od, 0, 0, 0);
#undef PK
}
DI void pv_d0(f32x16* o, int vb, bf16x8 pa0, bf16x8 pa1, bf16x8 pa2, bf16x8 pa3) {
  pv_one<0>(o[0], vb, pa0, pa1, pa2, pa3); pv_one<1>(o[1], vb, pa0, pa1, pa2, pa3); pv_one<2>(o[2], vb, pa0, pa1, pa2, pa3); pv_one<3>(o[3], vb, pa0, pa1, pa2, pa3);
}

template <int DK> struct AttnCfg {
  static constexpr float SCALE = DK == 64 ? 0.125f : (DK == 128 ? 0.08838834764831845f : 0.07216878364870322f);
  static constexpr float C = SCALE * 1.4426950408889634f;
  static constexpr int KROW = DK * 2;
  static constexpr int SHM_V = KVBLK * 128 * 2, SHM_K = KVBLK * DK * 2;
};

template <int DK, bool MASKED> DI void partialSM(f32x16& p0, f32x16& p1, float& m_reg, float& mn, float& alpha, bool masked, int mb, int hi) {
  constexpr float C = AttnCfg<DK>::C, SCALE = AttnCfg<DK>::SCALE;
  if constexpr (MASKED) if (masked) {
#pragma unroll
    for (int r = 0; r < 16; ++r) { const int d0 = mb + crow(r, hi), d1 = d0 + 32;
      p0[r] = (d0 < -128 || d0 > 128) ? -1e30f : p0[r]; p1[r] = (d1 < -128 || d1 > 128) ? -1e30f : p1[r]; }
  }
  float pmax = p0[0];
#pragma unroll
  for (int r = 1; r < 16; ++r) pmax = fmaxf(pmax, p0[r]);
#pragma unroll
  for (int r = 0; r < 16; ++r) pmax = fmaxf(pmax, p1[r]);
  { auto rr = __builtin_amdgcn_permlane32_swap(__float_as_uint(pmax), __float_as_uint(pmax), false, false);
    pmax = fmaxf(__uint_as_float(rr[0]), __uint_as_float(rr[1])); }
  if (__builtin_expect(__all(pmax - m_reg <= THR / SCALE), 1)) { mn = m_reg; alpha = 1.f; }
  else { mn = fmaxf(m_reg, pmax); alpha = __builtin_amdgcn_exp2f((m_reg - mn) * C); m_reg = mn; }
  const float mnC = -mn * C;
#pragma unroll
  for (int r = 0; r < 16; ++r) p0[r] = fmaf(p0[r], C, mnC);
#pragma unroll
  for (int r = 0; r < 16; ++r) p1[r] = fmaf(p1[r], C, mnC);
#pragma unroll
  for (int r = 0; r < 16; ++r) p0[r] = __builtin_amdgcn_exp2f(p0[r]);
}
DI void finishSM(f32x16& p0, f32x16& p1, float alpha, float& l_reg, bf16x8& pa0, bf16x8& pa1, bf16x8& pa2, bf16x8& pa3) {
#pragma unroll
  for (int r = 0; r < 16; ++r) p1[r] = __builtin_amdgcn_exp2f(p1[r]);
  float ps = 0;
#pragma unroll
  for (int r = 0; r < 16; ++r) ps += p0[r];
#pragma unroll
  for (int r = 0; r < 16; ++r) ps += p1[r];
  { auto rr = __builtin_amdgcn_permlane32_swap(__float_as_uint(ps), __float_as_uint(ps), false, false);
    ps = __uint_as_float(rr[0]) + __uint_as_float(rr[1]); }
  l_reg = l_reg * alpha + ps;
#define PK4(P, BASE, OUT) do { unsigned a0 = cvtpk(P[BASE + 0], P[BASE + 1]), a1 = cvtpk(P[BASE + 2], P[BASE + 3]);   \
    unsigned b0 = cvtpk(P[BASE + 4], P[BASE + 5]), b1 = cvtpk(P[BASE + 6], P[BASE + 7]);                              \
    auto r0 = __builtin_amdgcn_permlane32_swap(a0, b0, false, false); auto r1 = __builtin_amdgcn_permlane32_swap(a1, b1, false, false); \
    u32x4 w = {r0[0], r1[0], r0[1], r1[1]}; OUT = *reinterpret_cast<bf16x8*>(&w); } while (0)
  PK4(p0, 0, pa0); PK4(p0, 8, pa1); PK4(p1, 0, pa2); PK4(p1, 8, pa3);
#undef PK4
}
template <int DK, int KB  > DI void qkt(f32x16& p0, f32x16& p1, const LAS char* const (&xo)[4], const LAS char* const (&xo1)[4], const bf16x8* qr, const LAS char* const (&xq)[4]) {
  p0 = f32x16{}; p1 = f32x16{};
  constexpr int KROW = AttnCfg<DK>::KROW;
#pragma unroll
  for (int d0 = 0; d0 < DK / 16; ++d0) { const int k = d0 >> 2, m = d0 & 3;
    const LAS char* kbp = (DK == 128) ? (k ? xo1[m] : xo[m]) + KB : xo[m] + (KB + k * 128);
    const bf16x8 b0 = *(const LAS bf16x8*)(kbp);
    const bf16x8 b1 = *(const LAS bf16x8*)(kbp + 32 * KROW);
    bf16x8 qv;
    if constexpr (DK == 192) { if (d0 >= 8) qv = *(const LAS bf16x8*)(xq[m]); else qv = qr[d0 < 8 ? d0 : 0]; }
    else qv = qr[d0];
    p0 = __builtin_amdgcn_mfma_f32_32x32x16_bf16(b0, qv, p0, 0, 0, 0);
    p1 = __builtin_amdgcn_mfma_f32_32x32x16_bf16(b1, qv, p1, 0, 0, 0); }
}

template <int DK, bool MASKED>
DI void attn_body(const AttnItem& it, char* lds, int tid0) {
  using Cfg = AttnCfg<DK>;
  constexpr int SHM_V = Cfg::SHM_V, SHM_K = Cfg::SHM_K, KROW = Cfg::KROW;
  constexpr float C = Cfg::C;
#define KSWZ(row) (DK == 128 ? (((((row) & 7) | ((((row) >> 4) & 1) << 3))) << 4) : ((((row) >> 1) & 7) << 4))
  int tid = tid0; asm volatile("" : "+v"(tid));
  const int wid = tid >> 6, lane = tid & 63, r32 = lane & 31, hi = lane >> 5;
  char* V_lds = lds; char* K_lds = lds + 2 * SHM_V;
  char* Qr_lds = lds + 2 * SHM_V + 2 * SHM_K + 2048;
  float* wsf = (float*)(lds + 2 * SHM_V + 2 * SHM_K) + wid * 64; float* li_l = wsf; float* al_l = wsf + 32;
  const int sr = tid >> 4, sc = (tid & 15) * 8, vst0 = v_st(sr, sc), vst1 = v_st(32 + sr, sc);
  const int kr8 = tid >> 3, kc8 = (tid & 7) * 8;
  const int vb0 = (int)(uintptr_t)V_lds + v_rd_base(lane);
  const LAS char* xo[4]; const LAS char* xo1[4]; const LAS char* xq[4];
#pragma unroll
  for (int m = 0; m < 4; ++m) { const int t = ((m * 32 + hi * 16) ^ (KSWZ(r32) & 0x70)); const int hb = (DK == 128) ? ((r32 >> 4) & 1) * 128 : 0;
    xo[m] = (const LAS char*)K_lds + (r32 * KROW + t + hb); xo1[m] = (const LAS char*)K_lds + (r32 * KROW + t + (128 - hb)); xq[m] = (const LAS char*)Qr_lds + ((wid * QBLK + r32) * 128 + t); }
  constexpr int SDEPTH = (DK == 192) ? 1 : 2;
  struct { bf16x8 vs0, vs1, ks0, ks1, ks2; } sr_[SDEPTH];
#define KTROW(j) (((j) < 4 ? it.ctxrow0 : it.latrow0) + (j) * KVBLK)
  const long voV0 = (long)sr * it.ldv + sc, voV1 = (long)(32 + sr) * it.ldv + sc;
  const long voK0 = DK == 64 ? (long)kr8 * it.ldk + kc8 : (long)sr * it.ldk + sc, voK1 = (long)(32 + sr) * it.ldk + sc;
  const long voK2 = DK == 192 ? (long)kr8 * it.ldk2 + kc8 : 0;
#define SLOAD(i, j) do { const long _r = KTROW(j); const bf16_t* _vb = it.V + _r * it.ldv; const bf16_t* _kb = it.K + _r * it.ldk; \
    sr_[i].vs0 = *reinterpret_cast<const bf16x8*>(_vb + voV0); sr_[i].vs1 = *reinterpret_cast<const bf16x8*>(_vb + voV1); \
    sr_[i].ks0 = *reinterpret_cast<const bf16x8*>(_kb + voK0); \
    if constexpr (DK != 64) { sr_[i].ks1 = *reinterpret_cast<const bf16x8*>(_kb + voK1); } \
    if constexpr (DK == 192) { sr_[i].ks2 = *reinterpret_cast<const bf16x8*>(it.K2 + _r * it.ldk2 + voK2); } } while (0)
  SLOAD(0, 0); if constexpr (SDEPTH == 2) SLOAD(1, 1);
  constexpr int NQR = (DK == 192 ? 128 : DK) / 16;
  float m_reg = -1e30f, l_reg = 0; f32x16 o[4] = {}; bf16x8 qr[NQR];
  const bf16_t* Qw = it.Q + (long)(wid * QBLK + r32) * it.ldq + hi * 8;
#pragma unroll
  for (int d0 = 0; d0 < NQR; ++d0) qr[d0] = *reinterpret_cast<const bf16x8*>(Qw + d0 * 16);
  if constexpr (DK == 128) {
    if (it.qnorm || it.qrope) {
      const int pos = it.qpos0 + wid * QBLK + r32, prow = pos >> 6, pcol = pos & 63;
      const float* cosH = it.ropeB - 4096; const float* sinH = cosH + 2048;
      float f[8][8];
#pragma unroll
      for (int d0 = 0; d0 < 8; ++d0) unpack8(__builtin_bit_cast(u32x4, qr[d0]), f[d0]);
      if (it.qnorm) { float ss = 0.f;
#pragma unroll
        for (int d0 = 0; d0 < 8; ++d0)
#pragma unroll
          for (int j = 0; j < 8; ++j) ss += f[d0][j] * f[d0][j];
        ss += shfl_xor_l(ss, 32, lane); const float rn = rsqrtf(ss * (1.f / 128.f) + EPS);
#pragma unroll
        for (int d0 = 0; d0 < 8; ++d0) { const f32x8 g = *(const f32x8*)(it.qg + d0 * 16 + hi * 8);
#pragma unroll
          for (int j = 0; j < 8; ++j) f[d0][j] *= rn * g[j]; } }
      if (it.qrope) {
#pragma unroll
        for (int pr = 0; pr < 2; ++pr)
#pragma unroll
          for (int q2 = 0; q2 < 2; ++q2) { const int dA = pr * 4 + q2, dB = dA + 2; const int p = pr ? pcol : prow;
            const f32x8 cs = *(const f32x8*)(cosH + p * 32 + q2 * 16 + hi * 8), sn = *(const f32x8*)(sinH + p * 32 + q2 * 16 + hi * 8);
#pragma unroll
            for (int j = 0; j < 8; ++j) { const float x = f[dA][j], y = f[dB][j]; f[dA][j] = x * cs[j] - y * sn[j]; f[dB][j] = y * cs[j] + x * sn[j]; } } }
#pragma unroll
      for (int d0 = 0; d0 < 8; ++d0) qr[d0] = __builtin_bit_cast(bf16x8, pack8(f[d0]));
    }
  }
  if constexpr (DK == 64) {
    if (it.qrope) {
      const int pos = it.qpos0 + wid * QBLK + r32, prow = pos >> 6, pcol = pos & 63;
#pragma unroll
      for (int pr = 0; pr < 2; ++pr) { const float* cs = it.ropeB + (pr ? pcol : prow) * 16 + hi * 8; const float* sn = cs + 1024;
        float x[8], y[8]; unpack8(__builtin_bit_cast(u32x4, qr[2 * pr]), x); unpack8(__builtin_bit_cast(u32x4, qr[2 * pr + 1]), y);
#pragma unroll
        for (int j = 0; j < 8; ++j) { const float cj = cs[j], sj = sn[j], nx = x[j] * cj - y[j] * sj, ny = y[j] * cj + x[j] * sj; x[j] = nx; y[j] = ny; }
        qr[2 * pr] = __builtin_bit_cast(bf16x8, pack8(x)); qr[2 * pr + 1] = __builtin_bit_cast(bf16x8, pack8(y)); }
    }
  }
  if (PROBE_UNIFORM && it.probe) {
#pragma unroll
    for (int d0 = 0; d0 < NQR; ++d0) qr[d0] = (bf16x8){0, 0, 0, 0, 0, 0, 0, 0}; }
  __syncthreads();
  if constexpr (DK == 192) {
    const int pos = it.qpos0 + wid * QBLK + r32, prow = pos >> 6, pcol = pos & 63;
    char* qrow = Qr_lds + (wid * QBLK + r32) * 128;
#pragma unroll
    for (int pr = 0; pr < 2; ++pr) {
      u32x4 wa = *reinterpret_cast<const u32x4*>(Qw + (8 + 2 * pr) * 16), wb = *reinterpret_cast<const u32x4*>(Qw + (9 + 2 * pr) * 16);
      if (it.qrope) {
        const float* cs = it.ropeB + (pr ? pcol : prow) * 16 + hi * 8; const float* sn = cs + 1024;
        float a[8], b[8]; unpack8(wa, a); unpack8(wb, b);
        float na[8], nb[8];
#pragma unroll
        for (int j = 0; j < 8; ++j) { const float cj = cs[j], sj = sn[j]; na[j] = a[j] * cj - b[j] * sj; nb[j] = b[j] * cj + a[j] * sj; }
        wa = pack8(na); wb = pack8(nb);
      }
      if (PROBE_UNIFORM && it.probe) { wa = (u32x4){0u, 0u, 0u, 0u}; wb = wa; }
      *(u32x4*)(qrow + ((((2 * pr) * 16 + hi * 8) * 2) ^ KSWZ(r32))) = wa;
      *(u32x4*)(qrow + ((((2 * pr + 1) * 16 + hi * 8) * 2) ^ KSWZ(r32))) = wb;
    }
  }
#define KSW(row, colB) ((row) * KROW + ((colB) ^ KSWZ(row)))
#define SWRITE(b, i) do { *(bf16x8*)(V_lds + (b) * SHM_V + vst0) = sr_[i].vs0; *(bf16x8*)(V_lds + (b) * SHM_V + vst1) = sr_[i].vs1; \
    if constexpr (DK == 64) { *(bf16x8*)(K_lds + (b) * SHM_K + KSW(kr8, kc8 * 2)) = sr_[i].ks0; } \
    else { *(bf16x8*)(K_lds + (b) * SHM_K + KSW(sr, sc * 2)) = sr_[i].ks0; *(bf16x8*)(K_lds + (b) * SHM_K + KSW(32 + sr, sc * 2)) = sr_[i].ks1; } \
    if constexpr (DK == 192) { *(bf16x8*)(K_lds + (b) * SHM_K + KSW(kr8, 256 + kc8 * 2)) = sr_[i].ks2; } } while (0)
#define SWAIT() do { if constexpr (DK == 64) asm volatile("s_waitcnt vmcnt(3)" ::: "memory"); else if constexpr (DK == 128) asm volatile("s_waitcnt vmcnt(4)" ::: "memory"); else asm volatile("s_waitcnt vmcnt(0)" ::: "memory"); } while (0)
#define RESC(a) do { if (__any((a) < 1.f)) { if (hi == 0) al_l[r32] = (a); asm volatile("s_waitcnt lgkmcnt(0)" ::: "memory"); \
    _Pragma("unroll") for (int d = 0; d < 4; ++d) _Pragma("unroll") for (int r = 0; r < 16; ++r) o[d][r] *= al_l[crow(r, hi)]; } } while (0)
#define MB(j) (it.kpos0 + ((j) - 4) * KVBLK - qpos)
  const int qpos = it.qpos0 + wid * QBLK + r32;
  const bool msk = MASKED && it.mask != 0;
  f32x16 pA0, pA1, pB0, pB1; float mnA, mnB, alA, alB; bf16x8 pa0, pa1, pa2, pa3; const int NT = it.NT;
  constexpr int SE = 0, SO = SDEPTH - 1;
  asm volatile("s_waitcnt vmcnt(0)" ::: "memory"); SWRITE(0, SE); __syncthreads();
  qkt<DK, 0>(pA0, pA1, xo, xo1, qr, xq); partialSM<DK, MASKED>(pA0, pA1, m_reg, mnA, alA, false, 0, hi);
  if constexpr (SDEPTH == 2) { if (2 < NT) SLOAD(SE, 2); } else { SLOAD(SO, 1); }
  SWAIT(); SWRITE(1, SO); __syncthreads();
  for (int j = 1; j + 1 < NT; j += 2) {
    SBAR(); qkt<DK, SHM_K>(pB0, pB1, xo, xo1, qr, xq);
    finishSM(pA0, pA1, alA, l_reg, pa0, pa1, pa2, pa3); SBAR();
    SLOAD(SO, j + SDEPTH); SBAR();
    pv_d0(o, vb0, pa0, pa1, pa2, pa3); partialSM<DK, MASKED>(pB0, pB1, m_reg, mnB, alB, msk && j >= 4, MB(j), hi);
    __syncthreads(); SWAIT(); SWRITE(0, SE);
    RESC(alB); __syncthreads();
    SBAR(); qkt<DK, 0>(pA0, pA1, xo, xo1, qr, xq);
    finishSM(pB0, pB1, alB, l_reg, pa0, pa1, pa2, pa3); SBAR();
    if (SDEPTH == 1 || j + 3 < NT) SLOAD(SE, j + 1 + SDEPTH); SBAR();
    pv_d0(o, vb0 + SHM_V, pa0, pa1, pa2, pa3); partialSM<DK, MASKED>(pA0, pA1, m_reg, mnA, alA, msk && (j + 1) >= 4, MB(j + 1), hi);
    __syncthreads(); SWAIT(); SWRITE(1, SO);
    RESC(alA); __syncthreads();
  }
  SBAR(); qkt<DK, SHM_K>(pB0, pB1, xo, xo1, qr, xq);
  finishSM(pA0, pA1, alA, l_reg, pa0, pa1, pa2, pa3); SBAR();
  pv_d0(o, vb0, pa0, pa1, pa2, pa3); partialSM<DK, MASKED>(pB0, pB1, m_reg, mnB, alB, msk && (NT - 1) >= 4, MB(NT - 1), hi);
  __syncthreads(); RESC(alB);
  finishSM(pB0, pB1, alB, l_reg, pa0, pa1, pa2, pa3); SBAR();
  pv_d0(o, vb0 + SHM_V, pa0, pa1, pa2, pa3);
  if (it.has_sink) l_reg += __builtin_amdgcn_exp2f(it.sink_l2 - m_reg * C);
  if (hi == 0) li_l[r32] = l_reg; asm volatile("s_waitcnt lgkmcnt(0)" ::: "memory");
  float rli[16];
#pragma unroll
  for (int r = 0; r < 16; ++r) rli[r] = __builtin_amdgcn_rcpf(li_l[crow(r, hi)]);
  if (it.mode == 1) {
    float* sp = it.scratch + (size_t)wid * 4096 + lane;
#pragma unroll
    for (int d0 = 0; d0 < 4; ++d0)
#pragma unroll
      for (int r = 0; r < 16; ++r) sp[(d0 * 16 + r) * 64] = o[d0][r] * rli[r];
  } else {
    float rn[16];
    if (it.mode == 2) {
      const float* sp = it.scratch + (size_t)wid * 4096 + lane;
#pragma unroll
      for (int r = 0; r < 16; ++r) { float ss = 0.f;
#pragma unroll
        for (int d0 = 0; d0 < 4; ++d0) { const float v = sp[(d0 * 16 + r) * 64] - it.lam * (o[d0][r] * rli[r]); o[d0][r] = v; ss += v * v; }
#pragma unroll
        for (int m = 16; m >= 1; m >>= 1) ss += shfl_xor_l(ss, m, lane);
        rn[r] = rsqrtf(ss * (1.f / 128.f) + EPS) * it.sub_scale; }
    } else {
#pragma unroll
      for (int r = 0; r < 16; ++r) rn[r] = rli[r];
    }
    __syncthreads();
    constexpr int RS = 272;
    char* stg = lds + wid * (QBLK * RS);
#pragma unroll
    for (int r = 0; r < 16; ++r) { const int row = crow(r, hi);
#pragma unroll
      for (int d0 = 0; d0 < 4; ++d0) *(bf16_t*)(stg + row * RS + (d0 * 32 + r32) * 2) = f2bf(o[d0][r] * rn[r]); }
    asm volatile("s_waitcnt lgkmcnt(0)" ::: "memory");
    { const int row = lane >> 1, cb = (lane & 1) * 64;
      const bf16_t* zrow = it.Z + (size_t)(wid * QBLK + row) * NIN + cb; bf16_t* urow = it.UX + (size_t)(wid * QBLK + row) * DM + cb;
      u32x4 zv[8];
#pragma unroll
      for (int c = 0; c < 8; ++c) zv[c] = *(const u32x4*)(zrow + c * 8);
#pragma unroll
      for (int c = 0; c < 8; ++c) { float v[8], z[8]; unpack8(*(const u32x4*)(stg + row * RS + (cb + c * 8) * 2), v); unpack8(zv[c], z);
        if (it.mode == 2) { const f32x8 g = *(const f32x8*)(it.subg + cb + c * 8);
#pragma unroll
          for (int j = 0; j < 8; ++j) v[j] *= g[j]; }
#pragma unroll
        for (int j = 0; j < 8; ++j) v[j] *= silu(z[j]);
        *(u32x4*)(urow + c * 8) = pack8(v); } }
  }
#undef KTROW
#undef KSWZ
#undef SLOAD
#undef KSW
#undef SWRITE
#undef SWAIT
#undef RESC
#undef MB
}

template <bool F8>
DI void p0_tr_wave(const float* src, int K, int N, int scol0, void* dstv, int Kp, int kt, int n0, int lane) {
  const int k0 = kt * 64;
  if (k0 < K && scol0 >= 0) {
    const float* sp = src + (size_t)k0 * N + scol0 + lane;
#pragma unroll
    for (int h = 0; h < 2; ++h) {
      float v[32];
#pragma unroll
      for (int j = 0; j < 32; ++j) v[j] = sp[(size_t)(h * 32 + j) * N];
      if constexpr (F8) { unsigned char* drow = (unsigned char*)dstv + (size_t)(n0 + lane) * Kp + k0 + h * 32;
#pragma unroll
        for (int q = 0; q < 2; ++q) { u32x4 w;
#pragma unroll
          for (int e = 0; e < 4; ++e) w[e] = cvt4_fp8(v[q * 16 + e * 4] * W8_SCALE, v[q * 16 + e * 4 + 1] * W8_SCALE, v[q * 16 + e * 4 + 2] * W8_SCALE, v[q * 16 + e * 4 + 3] * W8_SCALE);
          *(u32x4*)(drow + q * 16) = w; } }
      else { bf16_t* drow = (bf16_t*)dstv + (size_t)(n0 + lane) * Kp + k0 + h * 32;
#pragma unroll
        for (int q = 0; q < 4; ++q) *(u32x4*)(drow + q * 8) = pack8(&v[q * 8]); }
    }
  } else {
    if constexpr (F8) { unsigned char* drow = (unsigned char*)dstv + (size_t)(n0 + lane) * Kp + k0;
#pragma unroll
      for (int q = 0; q < 4; ++q) *(u32x4*)(drow + q * 16) = (u32x4){0u, 0u, 0u, 0u}; }
    else { bf16_t* drow = (bf16_t*)dstv + (size_t)(n0 + lane) * Kp + k0;
#pragma unroll
      for (int q = 0; q < 8; ++q) *(u32x4*)(drow + q * 8) = (u32x4){0u, 0u, 0u, 0u}; }
  }
}
DI void p0_weights(const Args& a, int l, int wv_i, int wv_n, int lane) {
  unsigned char* Wt_in = a.ws + WS_WIN; bf16_t* Wt_out = (bf16_t*)(a.ws + WS_WOUT); bf16_t* Wt_uq = (bf16_t*)(a.ws + WS_WUQ); bf16_t* Wt_ukv = (bf16_t*)(a.ws + WS_WUKV);
  constexpr int T_IN8 = 32 * 68, T_INZ = 32 * 32, T_OUT = 32 * 32, T_UQ = 8 * 12, T_UKV = 4 * 16, T_L = T_IN8 + T_INZ + T_OUT + T_UQ + T_UKV;
  for (int tt = wv_i; tt < T_L; tt += wv_n) {
    int t = tt;
    if (t < T_IN8) { const int n0 = (t % 68) * 64; p0_tr_wave<true>(a.in[I_WIN] + (size_t)l * DM * NIN, DM, NIN, n0 < N8 ? map8(n0) : -1, Wt_in + (size_t)l * SZ_WIN, DM, t / 68, n0, lane); }
    else if ((t -= T_IN8) < T_INZ) { const int n0 = (t % 32) * 64; p0_tr_wave<false>(a.in[I_WIN] + (size_t)l * DM * NIN, DM, NIN, mapz(n0), Wt_in + (size_t)l * SZ_WIN + SZ_WIN8, DM, t / 32, n0, lane); }
    else if ((t -= T_INZ) < T_OUT) { const int n0 = (t % 32) * 64; p0_tr_wave<false>(a.in[I_WOUT] + (size_t)l * DM * DM, DM, DM, n0, Wt_out + (size_t)l * DM * DM, DM, t / 32, n0, lane); }
    else if ((t -= T_OUT) < T_UQ) { const int n0 = (t % 12) * 64; p0_tr_wave<false>(a.in[I_WUQ] + (size_t)l * 448 * 768, 448, 768, n0, Wt_uq + (size_t)l * 768 * 512, 512, t / 12, n0, lane); }
    else { t -= T_UQ; const int n0 = (t % 16) * 64; p0_tr_wave<false>(a.in[I_WUKV] + (size_t)l * 128 * 1024, 128, 1024, n0, Wt_ukv + (size_t)l * 1024 * 256, 256, t / 16, n0, lane); }
  }
}
DI void p0_sincos(double a, float& c, float& s) {
  const double TWO_PI = 6.283185307179586476925;
  double k = __builtin_rint(a / TWO_PI); double x = a - k * TWO_PI;
  double x2 = x * x, ts = x, tc = 1.0, ss = x, cs = 1.0;
  for (int n = 1; n <= 16; ++n) { tc *= -x2 / (double)((2 * n - 1) * (2 * n)); cs += tc; ts *= -x2 / (double)((2 * n) * (2 * n + 1)); ss += ts; }
  c = (float)cs; s = (float)ss;
}
DI void p0_phase(const Args& a, char* lds, int tid0) {
  int tid = tid0; asm volatile("" : "+v"(tid));
  const int G = gridDim.x, wid = tid >> 6, lane = tid & 63;
  float* fl = (float*)lds;
  unsigned char* Wt_in = a.ws + WS_WIN; bf16_t* Wt_out = (bf16_t*)(a.ws + WS_WOUT); bf16_t* Wt_uq = (bf16_t*)(a.ws + WS_WUQ); bf16_t* Wt_ukv = (bf16_t*)(a.ws + WS_WUKV);
  float* MOD = (float*)(a.ws + WS_MOD);
  constexpr int N_MOD = 2 * 24 * 16;
  for (int itx = blockIdx.x; itx < N_MOD; itx += G) {
    const int l = itx / 384, r0 = itx % 384, jb = r0 >> 4, kc = r0 & 15;
    float* sm = fl; float* red = fl + 9 * 128;
    for (int idx = tid; idx < 9 * 128; idx += 512) { const int r = idx >> 7, k = idx & 127;
      const float v = (r < 8) ? a.in[I_C][r * DM + kc * 128 + k] : a.in[I_CCTX][kc * 128 + k]; sm[idx] = silu(v); }
    __syncthreads();
    f32x4 acc[9];
#pragma unroll
    for (int r = 0; r < 9; ++r) acc[r] = (f32x4){0.f, 0.f, 0.f, 0.f};
    const float* wp = a.in[I_WMOD] + (size_t)l * DM * 6144 + (size_t)(kc * 128 + wid * 16) * 6144 + jb * 256 + lane * 4;
#pragma unroll
    for (int kk = 0; kk < 16; ++kk) { const f32x4 wv = *(const f32x4*)(wp + (size_t)kk * 6144);
#pragma unroll
      for (int r = 0; r < 9; ++r) acc[r] += sm[r * 128 + wid * 16 + kk] * wv; }
#pragma unroll
    for (int r = 0; r < 9; ++r) *(f32x4*)(red + (wid * 9 + r) * 256 + lane * 4) = acc[r];
    __syncthreads();
    for (int idx = tid; idx < 9 * 256; idx += 512) { const int r = idx >> 8, cidx = idx & 255; float sum = 0.f;
#pragma unroll
      for (int w = 0; w < 8; ++w) sum += red[(w * 9 + r) * 256 + cidx];
      if (kc == 0) sum += a.in[I_BMOD][l * 6144 + jb * 256 + cidx];
      atomicAdd(MOD + (size_t)(l * 9 + r) * 6144 + jb * 256 + cidx, sum); }
    __syncthreads();
  }
  if (blockIdx.x == 0) {
    float* rope = (float*)(a.ws + WS_ROPE);
    for (int idx = tid; idx < 3072; idx += 512) {
      int pos, fi, nf; float* cdst; float* sdst;
      if (idx < 2048) { pos = idx >> 5; fi = idx & 31; nf = 32; cdst = rope + idx; sdst = rope + 2048 + idx; }
      else { const int i2 = idx - 2048; pos = i2 >> 4; fi = i2 & 15; nf = 16; cdst = rope + 4096 + i2; sdst = rope + 5120 + i2; }
      double f = 1.0; const int e = fi * (32 / nf); for (int q = 0; q < e; ++q) f *= 0.7498942093324559;
      float c, sn; p0_sincos((double)pos * f, c, sn); *cdst = c; *sdst = sn;
    }
  }
  p0_weights(a, 0, blockIdx.x * 8 + wid, G * 8, lane);
}

DI void prenorm_phase(const Args& a, int l, int tid0) {
  int tid = tid0; asm volatile("" : "+v"(tid));
  const int wid = tid >> 6, lane = tid & 63;
  const float* xs = l == 0 ? a.in[I_X] : a.out; const float* cs = l == 0 ? a.in[I_CTX] : (const float*)(a.ws + WS_CTX1);
  const float* g = a.in[I_NORMG] + l * DM; const float* MOD = (const float*)(a.ws + WS_MOD) + (size_t)l * 9 * 6144;
  bf16_t* H = (bf16_t*)(a.ws + WS_H); unsigned char* H8 = a.ws + WS_H8;
  const int nw = gridDim.x * 8, per = (MTOT + nw - 1) / nw, gw = blockIdx.x * 8 + wid;
  int row = gw * per; const int rend = (row + per < MTOT) ? row + per : MTOT;
  if (row >= rend) return;
  f32x4 A[8], Bv[8], va[8], vb[8]; int cur_m = -1;
#define PRE_LOAD(V, r) do { const float* _src = (r) < MCTX ? cs + (size_t)(r) * DM : xs + (size_t)((r) - MCTX) * DM; \
    _Pragma("unroll") for (int i = 0; i < 8; ++i) V[i] = *(const f32x4*)(_src + (i * 64 + lane) * 4); } while (0)
#define PRE_PROC(V, r) do { const int _m = (r) < MCTX ? 8 : (((r) - MCTX) >> 12); \
    if (_m != cur_m) { cur_m = _m; const float* mod = MOD + _m * 6144; \
      _Pragma("unroll") for (int i = 0; i < 8; ++i) { const int col = (i * 64 + lane) * 4; A[i] = *(const f32x4*)(g + col) * (*(const f32x4*)(mod + 2048 + col) + 1.f); Bv[i] = *(const f32x4*)(mod + col); } } \
    float ss = 0.f; \
    _Pragma("unroll") for (int i = 0; i < 8; ++i) ss += V[i][0] * V[i][0] + V[i][1] * V[i][1] + V[i][2] * V[i][2] + V[i][3] * V[i][3]; \
    ss = wave_sum(ss, lane); const float rstd = rsqrtf(ss * (1.f / DM) + EPS); \
    _Pragma("unroll") for (int i = 0; i < 8; ++i) { const int col = (i * 64 + lane) * 4; const f32x4 y = V[i] * rstd * A[i] + Bv[i]; \
      u32x2 w = {cvtpk(y[0], y[1]), cvtpk(y[2], y[3])}; *(u32x2*)(H + (size_t)(r) * DM + col) = w; \
      *(unsigned*)(H8 + (size_t)(r) * DM + col) = cvt4_fp8(y[0] * A8_SCALE, y[1] * A8_SCALE, y[2] * A8_SCALE, y[3] * A8_SCALE); } } while (0)
  { const int _m = row < MCTX ? 8 : ((row - MCTX) >> 12); cur_m = _m; const float* mod = MOD + _m * 6144;
#pragma unroll
    for (int i = 0; i < 8; ++i) { const int col = (i * 64 + lane) * 4; A[i] = *(const f32x4*)(g + col) * (*(const f32x4*)(mod + 2048 + col) + 1.f); Bv[i] = *(const f32x4*)(mod + col); } }
  PRE_LOAD(va, row);
  for (; row < rend; row += 2) {
    { const int rn = row + 1 < rend ? row + 1 : rend - 1; PRE_LOAD(vb, rn); }
    __builtin_amdgcn_sched_barrier(0);
    PRE_PROC(va, row);
    __builtin_amdgcn_sched_barrier(0);
    { const int rn = row + 2 < rend ? row + 2 : rend - 1; PRE_LOAD(va, rn); }
    __builtin_amdgcn_sched_barrier(0);
    if (row + 1 < rend) PRE_PROC(vb, row + 1);
    __builtin_amdgcn_sched_barrier(0);
  }
#undef PRE_LOAD
#undef PRE_PROC
}

DI void rope8(float* x, float* y, const f32x8 cs, const f32x8 sn) {
#pragma unroll
  for (int j = 0; j < 8; ++j) { const float nx = x[j] * cs[j] - y[j] * sn[j], ny = y[j] * cs[j] + x[j] * sn[j]; x[j] = nx; y[j] = ny; }
}
DI void post_phase(const Args& a, int l, int tid0) {
  int tid = tid0; asm volatile("" : "+v"(tid));
  const int wid = tid >> 6, lane = tid & 63;
  const float* rope = (const float*)(a.ws + WS_ROPE); const float* cosH = rope; const float* sinH = rope + 2048; const float* cosB = rope + 4096; const float* sinB = rope + 5120;
  bf16_t* PROJ = (bf16_t*)(a.ws + WS_PROJ); bf16_t* CQN = (bf16_t*)(a.ws + WS_CQN); bf16_t* CKVN = (bf16_t*)(a.ws + WS_CKVN);
  const float* cqg = a.in[I_CQG] + l * 448; const float* ckvg = a.in[I_CKVG] + l * 128; const float* dkg = a.in[I_DKG] + l * 128;
  const bool is128 = lane < 32;
  const int tA = lane & 7, cA = (tA < 4) ? tA : tA + 4, tB = lane & 3, cB = (tB < 2) ? tB : tB + 2;
  const int colL = is128 ? (lane < 16 ? C_AK : C_DK) + ((lane >> 3) & 1) * 128 + cA * 8 : C_BK + ((lane - 32) >> 2) * 64 + cB * 8;
  const int colH = colL + (is128 ? 32 : 16);
  const int cq_l = lane < 56 ? lane : 55, ck_l = lane < 16 ? lane : 15;
  f32x8 gdL, gdH, gcq, gck;
  { gdL = *(const f32x8*)(dkg + cA * 8); gdH = *(const f32x8*)(dkg + (cA + 4) * 8); gcq = *(const f32x8*)(cqg + cq_l * 8); gck = *(const f32x8*)(ckvg + ck_l * 8); }
  const int nw = gridDim.x * 8, per = (MTOT + nw - 1) / nw, gw = blockIdx.x * 8 + wid;
  const int r0 = gw * per, rend = (r0 + per < MTOT) ? r0 + per : MTOT;
  for (int row = r0; row < rend; ++row) {
    bf16_t* p = PROJ + (size_t)row * NIN;
    const bool lat = row >= MCTX; const int pos = lat ? ((row - MCTX) & 4095) : 0, prow = pos >> 6, pcol = pos & 63;
    const u32x4 uL = *(const u32x4*)(p + colL), uH = *(const u32x4*)(p + colH);
    const u32x4 kL = *(const u32x4*)(p + C_KR + cB * 8), kH = *(const u32x4*)(p + C_KR + (cB + 2) * 8);
    const u32x4 cq = *(const u32x4*)(p + C_CQ + cq_l * 8), ck = *(const u32x4*)(p + C_CKV + ck_l * 8);
    const int pH = (tA < 4) ? prow : pcol, pB = (tB < 2) ? prow : pcol;
    const float* csp = is128 ? cosH + pH * 32 + (tA & 3) * 8 : cosB + pB * 16 + (tB & 1) * 8;
    const f32x8 csU = *(const f32x8*)csp, snU = *(const f32x8*)(csp + (is128 ? 2048 : 1024));
    const f32x8 csB = *(const f32x8*)(cosB + pB * 16 + (tB & 1) * 8), snB = *(const f32x8*)(sinB + pB * 16 + (tB & 1) * 8);
    __builtin_amdgcn_sched_barrier(0);
    float x[8], y[8];
    { unpack8(uL, x); unpack8(uH, y); float ss = 0.f;
#pragma unroll
      for (int j = 0; j < 8; ++j) ss += x[j] * x[j] + y[j] * y[j];
      ss += shfl_xor_l(ss, 1, lane); ss += shfl_xor_l(ss, 2, lane); ss += shfl_xor_l(ss, 4, lane);
      const bool isd = lane >= 16 && lane < 32;
      const float rn = rsqrtf(ss * (1.f / 128.f) + EPS);
#pragma unroll
      for (int j = 0; j < 8; ++j) { x[j] = isd ? x[j] * rn * gdL[j] : x[j]; y[j] = isd ? y[j] * rn * gdH[j] : y[j]; }
      if (lat) rope8(x, y, csU, snU);
      if (lat || isd) { *(u32x4*)(p + colL) = pack8(x); *(u32x4*)(p + colH) = pack8(y); } }
    if (lat) { unpack8(kL, x); unpack8(kH, y); rope8(x, y, csB, snB);
      if (lane < 4) { *(u32x4*)(p + C_KR + cB * 8) = pack8(x); *(u32x4*)(p + C_KR + (cB + 2) * 8) = pack8(y); } }
    { unpack8(cq, x); float ss = 0.f;
#pragma unroll
      for (int j = 0; j < 8; ++j) ss += x[j] * x[j];
      ss = wave_sum(lane < 56 ? ss : 0.f, lane); const float rn = rsqrtf(ss * (1.f / 448.f) + EPS);
#pragma unroll
      for (int j = 0; j < 8; ++j) x[j] = lane < 56 ? x[j] * rn * gcq[j] : 0.f;
      *(u32x4*)(CQN + (size_t)row * 512 + lane * 8) = pack8(x); }
    { unpack8(ck, x); float ss = 0.f;
#pragma unroll
      for (int j = 0; j < 8; ++j) ss += x[j] * x[j];
      ss = wave_sum(lane < 16 ? ss : 0.f, lane); const float rn = rsqrtf(ss * (1.f / 128.f) + EPS);
#pragma unroll
      for (int j = 0; j < 8; ++j) x[j] = lane < 16 ? x[j] * rn * gck[j] : 0.f;
      if (lane < 32) *(u32x4*)(CKVN + (size_t)row * 256 + lane * 8) = pack8(x); }
  }
}

DI void attn_phase(const Args& a, int l, char* lds, int tid0) {
  const int G = gridDim.x, bx = blockIdx.x; const int vcu = (G % 8 == 0) ? (bx % 8) * (G / 8) + bx / 8 : bx;
  const int nitems = 2048 + (l == 0 ? 128 : 0);
  const bf16_t* PROJ = (const bf16_t*)(a.ws + WS_PROJ); const bf16_t* CQH = (const bf16_t*)(a.ws + WS_CQH); const bf16_t* CKVH = (const bf16_t*)(a.ws + WS_CKVH);
  bf16_t* UX = (bf16_t*)(a.ws + WS_H);
  const float* bl = a.in[I_LAMBDA] + l * 256; float s1 = 0.f, s2 = 0.f;
  for (int i = 0; i < 64; ++i) { s1 += bl[i] * bl[64 + i]; s2 += bl[128 + i] * bl[192 + i]; }
  const float lam_init = l == 0 ? 0.2f : 0.35550906759096934f;
  const float lam = expf(s1) - expf(s2) + lam_init;
  for (int L = vcu; L < nitems; L += G) {
    int type, b, h, qb; bool isctx;
    if (L < 2048) { type = L >> 9; const int r = L & 511; b = r >> 6; h = (r >> 4) & 3; qb = r & 15; isctx = false; }
    else { int r = L - 2048; type = r >> 5; r &= 31; b = r >> 2; h = r & 3; qb = 0; isctx = true; }
    const int qrow0 = isctx ? b * 256 : MCTX + b * SEQ + qb * 256;
    AttnItem it;
    it.ctxrow0 = b * 256; it.latrow0 = MCTX + b * SEQ - 256; it.NT = isctx ? 4 : 68;
    it.mask = 0; it.qpos0 = qb * 256; it.kpos0 = 0; it.has_sink = 0; it.sink_l2 = 0.f; it.qrope = isctx ? 0 : 1; it.qnorm = 0; it.qg = a.in[I_DQG] + l * 128; it.ropeB = (const float*)(a.ws + WS_ROPE) + 4096;
    it.mode = 0; it.lam = lam; it.sub_scale = 1.f - lam_init; it.subg = a.in[I_SUBLN] + l * 128; it.scratch = (float*)(a.ws + WS_DIFF) + (size_t)bx * 32768;
    it.K2 = nullptr; it.ldk2 = 0; it.probe = (PROBE_UNIFORM == 1 && type == 1) || (PROBE_UNIFORM == 2 && type == 2) || (PROBE_UNIFORM == 3 && type == 3);
    if (type == 0) {
      it.V = PROJ + C_BV + h * 128; it.ldv = NIN; it.ldq = NIN; it.ldk = NIN;
      it.Z = PROJ + (size_t)qrow0 * NIN + C_BZ + h * 128; it.UX = UX + (size_t)qrow0 * DM + 512 + h * 128;
      for (int c = 0; c < 2; ++c) {
        it.Q = PROJ + (size_t)qrow0 * NIN + C_BQ + (2 * h + c) * 64; it.K = PROJ + C_BK + (2 * h + c) * 64; it.mode = 1 + c;
        attn_body<64, false>(it, lds, tid0);
      }
    } else if (type == 1) {
      it.Q = CQH + (size_t)qrow0 * 768 + h * 192; it.ldq = 768; it.K = CKVH + h * 256; it.ldk = 1024; it.K2 = PROJ + C_KR; it.ldk2 = NIN;
      it.V = CKVH + h * 256 + 128; it.ldv = 1024;
      it.Z = PROJ + (size_t)qrow0 * NIN + C_CZ + h * 128; it.UX = UX + (size_t)qrow0 * DM + 1024 + h * 128;
      attn_body<192, false>(it, lds, tid0);
    } else if (type == 2) {
      it.Q = PROJ + (size_t)qrow0 * NIN + C_DQ + h * 128; it.ldq = NIN; it.K = PROJ + C_DK + (h >> 1) * 128; it.ldk = NIN; it.V = PROJ + C_DV + (h >> 1) * 128; it.ldv = NIN;
      it.Z = PROJ + (size_t)qrow0 * NIN + C_DZ + h * 128; it.UX = UX + (size_t)qrow0 * DM + 1536 + h * 128; it.qnorm = 1;
      attn_body<128, false>(it, lds, tid0);
    } else {
      it.Q = PROJ + (size_t)qrow0 * NIN + C_AQ + h * 128; it.ldq = NIN; it.K = PROJ + C_AK + (h >> 1) * 128; it.ldk = NIN; it.V = PROJ + C_AV + (h >> 1) * 128; it.ldv = NIN;
      it.Z = PROJ + (size_t)qrow0 * NIN + C_AZ + h * 128; it.UX = UX + (size_t)qrow0 * DM + h * 128;
      it.has_sink = 1; it.sink_l2 = a.in[I_SINK][l * 4 + h] * 1.4426950408889634f;
      if (!isctx) { const int i0 = qb * 256; const int ks = i0 - 128 < 0 ? 0 : i0 - 128; const int ke = i0 + 384 > SEQ ? SEQ : i0 + 384;
        it.NT = 4 + (ke - ks) / 64; it.latrow0 = MCTX + b * SEQ + ks - 256; it.mask = 1; it.kpos0 = ks; }
      if (isctx) attn_body<128, false>(it, lds, tid0); else attn_body<128, true>(it, lds, tid0);
    }
  }
}

DI void final_phase(const Args& a, int tid0) {
  int tid = tid0; asm volatile("" : "+v"(tid));
  const int wid = tid >> 6, lane = tid & 63; const float* g = a.in[I_FNG];
  const int nw = gridDim.x * 8, per = (MLAT + nw - 1) / nw, gw = blockIdx.x * 8 + wid;
  int row = gw * per; const int rend = (row + per < MLAT) ? row + per : MLAT;
  if (row >= rend) return;
  f32x4 gv[8], va[8], vb[8];
#pragma unroll
  for (int i = 0; i < 8; ++i) gv[i] = *(const f32x4*)(g + (i * 64 + lane) * 4);
#define FIN_LOAD(V, r) do { _Pragma("unroll") for (int i = 0; i < 8; ++i) V[i] = *(const f32x4*)(a.out + (size_t)(r) * DM + (i * 64 + lane) * 4); } while (0)
#define FIN_PROC(V, r) do { float ss = 0.f; \
    _Pragma("unroll") for (int i = 0; i < 8; ++i) ss += V[i][0] * V[i][0] + V[i][1] * V[i][1] + V[i][2] * V[i][2] + V[i][3] * V[i][3]; \
    ss = wave_sum(ss, lane); const float rstd = rsqrtf(ss * (1.f / DM) + EPS); \
    _Pragma("unroll") for (int i = 0; i < 8; ++i) *(f32x4*)(a.out + (size_t)(r) * DM + (i * 64 + lane) * 4) = V[i] * rstd * gv[i]; } while (0)
  FIN_LOAD(va, row);
  for (; row < rend; row += 2) {
    { const int rn = row + 1 < rend ? row + 1 : rend - 1; FIN_LOAD(vb, rn); }
    __builtin_amdgcn_sched_barrier(0);
    FIN_PROC(va, row);
    __builtin_amdgcn_sched_barrier(0);
    { const int rn = row + 2 < rend ? row + 2 : rend - 1; FIN_LOAD(va, rn); }
    __builtin_amdgcn_sched_barrier(0);
    if (row + 1 < rend) FIN_PROC(vb, row + 1);
    __builtin_amdgcn_sched_barrier(0);
  }
#undef FIN_LOAD
#undef FIN_PROC
}

constexpr int N_PHASES = 14;
__global__ void __launch_bounds__(512, 2) fwd_mega(Args a0) {
  const Args& a = a0;
  extern __shared__ __attribute__((aligned(16))) unsigned char lds[];
  const int lo = a.ph_lo, hi = a.ph_hi;
  volatile LAS unsigned* xst = (volatile LAS unsigned*)((LAS unsigned char*)lds + LDS_BYTES);
  const int wv = __builtin_amdgcn_readfirstlane((int)threadIdx.x >> 6);
#define TID() (wv * 64 + lane_id())
  if (TID() < 4) xst[TID()] = 0u;
  __syncthreads();
  XcdBarrier xbar; xbar.bar = (unsigned*)(a.ws + WS_BAR); xbar.x = 0; xbar.st = xst;
  if (hi - lo > 1) xbar = xcd_barrier_post((unsigned*)(a.ws + WS_BAR), xst, TID() == 0);
#define IN(k) (lo <= (k) && (k) < hi)
#define SEAM(k) do { if (IN(k) && IN((k) + 1)) xcd_barrier(xbar, TID() == 0); } while (0)
  if (hi > 1000) cg::this_grid().sync();
  if (IN(0)) p0_phase(a, (char*)lds, TID());
  SEAM(0);
  for (int l = 0; l < 2; ++l) {
    const int pb = 1 + 6 * l;
#define FRESH(b) Args b = a0; asm volatile("" : "+s"(b.ws), "+s"(b.out))
    if (IN(pb)) { FRESH(a); prenorm_phase(a, l, TID()); }
    SEAM(pb);
    if (IN(pb + 1)) { FRESH(a);
      { pg8::Gemm g{(const bf16_t*)(a.ws + WS_H8), (const bf16_t*)(a.ws + WS_WIN + (size_t)l * SZ_WIN), MTOT, N8P, DM};
        pg8::SkewOrder S; S.init(MTOT, N8P, gridDim.x, blockIdx.x); S.lo = (((l == 0 ? MTOT : MLAT) / 256) * (DM / 256)) % gridDim.x; S.skip = (S.lo > 0 && S.lo < (int)gridDim.x && S.nwg / S.G >= 2) ? 1 : 0; if (S.skip == 0) S.lo = 0;
        pg8::EpiBf16 E{(bf16_t*)(a.ws + WS_PROJ), NIN, N8, 1, 1.f / (A8_SCALE * W8_SCALE)};
        pg8::gemm_phase<pg8::EpiBf16, pg8::SkewOrder, true>((LAS unsigned char*)lds, g, S, E, TID()); }
      { const int roff = l == 0 ? 0 : MCTX, Mg = MTOT - roff;
        pg8::Gemm g{(const bf16_t*)(a.ws + WS_H) + (size_t)roff * DM, (const bf16_t*)(a.ws + WS_WIN + (size_t)l * SZ_WIN + SZ_WIN8), Mg, DM, DM};
        pg8::StaticOrder S; S.init(Mg, DM, gridDim.x, blockIdx.x);
        pg8::EpiBf16 E{(bf16_t*)(a.ws + WS_PROJ) + (size_t)roff * NIN, NIN, DM, 2, 1.f};
        pg8::gemm_phase<pg8::EpiBf16, pg8::StaticOrder>((LAS unsigned char*)lds, g, S, E, TID()); }
    }
    SEAM(pb + 1);
    if (IN(pb + 2)) { FRESH(a); post_phase(a, l, TID()); }
    SEAM(pb + 2);
    if (IN(pb + 3)) { FRESH(a);
      { const int roff = l == 0 ? 0 : MCTX, Mq = MTOT - roff;
        pg8::Gemm g{(const bf16_t*)(a.ws + WS_CQN) + (size_t)roff * 512, (const bf16_t*)(a.ws + WS_WUQ + (size_t)l * SZ_WUQ), Mq, 768, 512};
        pg8::StaticOrder S; S.init(Mq, 768, gridDim.x, blockIdx.x);
        pg8::EpiBf16 E{(bf16_t*)(a.ws + WS_CQH) + (size_t)roff * 768, 768, 768, 0, 1.f};
        pg8::gemm_phase<pg8::EpiBf16, pg8::StaticOrder>((LAS unsigned char*)lds, g, S, E, TID()); }
      { pg8::Gemm g{(const bf16_t*)(a.ws + WS_CKVN), (const bf16_t*)(a.ws + WS_WUKV + (size_t)l * SZ_WUKV), MTOT, 1024, 256};
        pg8::StaticOrder S; S.init(MTOT, 1024, gridDim.x, blockIdx.x);
        pg8::EpiBf16 E{(bf16_t*)(a.ws + WS_CKVH), 1024, 1024, 0, 1.f};
        pg8::gemm_phase<pg8::EpiBf16, pg8::StaticOrder>((LAS unsigned char*)lds, g, S, E, TID()); }
    }
    SEAM(pb + 3);
    if (IN(pb + 4)) { FRESH(a); attn_phase(a, l, (char*)lds, TID()); }
    SEAM(pb + 4);
    if (IN(pb + 5)) { FRESH(a);
      const int roff = l == 0 ? 0 : MCTX; const int M = MTOT - roff;
      pg8::Gemm g{(const bf16_t*)(a.ws + WS_H) + (size_t)roff * DM, (const bf16_t*)(a.ws + WS_WOUT + (size_t)l * SZ_WOUT), M, DM, DM};
      pg8::StaticOrder S; S.init(M, DM, gridDim.x, blockIdx.x);
      pg8::EpiResid E{a.in[I_CTX], l == 0 ? a.in[I_X] : (const float*)a.out, (float*)(a.ws + WS_CTX1), a.out, (const float*)(a.ws + WS_MOD) + (size_t)l * 9 * 6144, roff};
      pg8::gemm_phase<pg8::EpiResid, pg8::StaticOrder>((LAS unsigned char*)lds, g, S, E, TID());
      if (l == 0) {
        const int Gx = gridDim.x, extra = (MTOT / 256) * (DM / 256) % Gx, bxx = blockIdx.x;
        if (extra == 0) { const int t2 = TID(); p0_weights(a, 1, bxx * 8 + (t2 >> 6), Gx * 8, t2 & 63); }
        else if (bxx >= extra) { const int t2 = TID(); p0_weights(a, 1, (bxx - extra) * 8 + (t2 >> 6), (Gx - extra) * 8, t2 & 63); }
      }
    }
    SEAM(pb + 5);
  }
  if (IN(13)) final_phase(a, TID());
#undef IN
#undef SEAM
}

extern "C" void kernel_launch(void* const* d_in, const int* in_sizes, int n_in, void* d_out, int out_size, void* d_ws, size_t ws_size, hipStream_t stream) {
  static int grid = 0;
  if (grid == 0) {
    if (n_in != 19 || out_size != MLAT * DM || ws_size < WS_END) { fprintf(stderr, "kernel_launch: unexpected shapes (n_in %d out %d ws %zu, need %zu)\n", n_in, out_size, ws_size, (size_t)WS_END); grid = -1; return; }
    int dev = 0, cus = 0, per_cu = 0;
    hipGetDevice(&dev); hipDeviceGetAttribute(&cus, hipDeviceAttributeMultiprocessorCount, dev);
    if (hipFuncSetAttribute((const void*)fwd_mega, hipFuncAttributeMaxDynamicSharedMemorySize, LDS_BYTES + 16) != hipSuccess) { fprintf(stderr, "kernel_launch: hipFuncSetAttribute failed\n"); grid = -1; return; }
    if (hipOccupancyMaxActiveBlocksPerMultiprocessor(&per_cu, (const void*)fwd_mega, 512, LDS_BYTES + 16) != hipSuccess || per_cu < 1) { fprintf(stderr, "kernel_launch: occupancy query gave %d\n", per_cu); per_cu = 1; }
    (void)hipGetLastError();
    grid = cus * per_cu; if (grid > 256) grid = 256;
  }
  if (grid < 0) return;
  hipMemsetAsync((char*)d_ws + WS_BAR, 0, 16384 + SZ_MOD, stream);
  Args a{};
  for (int i = 0; i < 19; ++i) a.in[i] = (const float*)d_in[i];
  a.out = (float*)d_out; a.ws = (unsigned char*)d_ws;
#if COOP
  a.ph_lo = 0; a.ph_hi = N_PHASES;
  void* args[] = {&a};
  hipError_t e = hipLaunchCooperativeKernel((const void*)fwd_mega, dim3(grid), dim3(512), args, LDS_BYTES + 16, stream);
  if (e != hipSuccess) fprintf(stderr, "cooperative launch failed: %s (grid %d)\n", hipGetErrorString(e), grid);
#else
  for (int p = 0; p < N_PHASES; ++p) { a.ph_lo = p; a.ph_hi = p + 1; hipLaunchKernelGGL(fwd_mega, dim3(grid), dim3(512), LDS_BYTES + 16, stream, a); }
#endif
}
```
